# Optimizing an MI355X kernel written in HIP

```python
import math
import jax, jax.numpy as jnp
from jax import lax
import numpy as np

D_MODEL = 1024
BATCH = 1
SEQ = 16384
DEPTH = 2

GRID_W = 64
CTX_LEN = 256
EPS = 1e-6
ROPE_BASE = 10000.0
Q_BLOCK = 128
M_HEADS = 4
M_DK = 128
M_DV = 128
M_CHUNK = 64
GATE_SOFTCAP = 15.0
A_HEADS = 8
A_NOPE = 64
A_ROPE = 32
A_V = 64
Q_LORA = 256
KV_LORA = 128
DF_HEADS = 4
DF_DK = 64
DF_DV = 128
N_BRANCH = 3
BRANCH_W = 512
N_EXPERTS = 32
TOP_K = 4
D_EXPERT = 1024
SWIGLU_LIMIT = 7.0
SWIGLU_ALPHA = 1.702
MOE_BLOCK = 128

IN_SIZES = (M_HEADS * M_DK, M_HEADS * M_DK, M_HEADS * M_DV, M_HEADS * M_DV, 4 * M_HEADS,
            Q_LORA, KV_LORA, A_ROPE,
            2 * DF_HEADS * DF_DK, 2 * DF_HEADS * DF_DK, DF_HEADS * DF_DV,
            N_BRANCH * D_MODEL)
D_IN = sum(IN_SIZES)

kernel_name = 'hybrid_mlstm_mla_diffattn_moe_dit'

f32 = jnp.float32


def rms_norm(x, g):
    xf = x.astype(f32)
    y = xf * lax.rsqrt(jnp.mean(xf * xf, axis=-1, keepdims=True) + EPS)
    return (y * g.astype(f32)).astype(x.dtype)


def heads(t, n):
    b, l, _ = t.shape
    return t.reshape(b, l, n, -1).transpose(0, 2, 1, 3)


def merge_heads(t):
    b, h, l, d = t.shape
    return t.transpose(0, 2, 1, 3).reshape(b, l, h * d)


def axial_rope(rows, dim):
    row = jnp.repeat(jnp.arange(rows, dtype=f32), GRID_W)
    col = jnp.tile(jnp.arange(GRID_W, dtype=f32), rows)
    quarter = dim // 4
    inv = ROPE_BASE ** (-jnp.arange(quarter, dtype=f32) / quarter)
    ang = jnp.concatenate([row[:, None] * inv, col[:, None] * inv], axis=-1)
    return jnp.cos(ang), jnp.sin(ang)


def apply_rope(x, rope):
    if rope is None:
        return x
    cos, sin = rope
    half = x.shape[-1] // 2
    x1 = x[..., :half].astype(f32)
    x2 = x[..., half:].astype(f32)
    return jnp.concatenate([x1 * cos - x2 * sin, x1 * sin + x2 * cos], axis=-1).astype(x.dtype)


def adaln(cond, w, b):
    m = jnp.einsum('...d,de->...e', jax.nn.silu(cond), w) + b
    return jnp.split(m, 6, axis=-1)


def modulate(x, g, shift, scale):
    return rms_norm(x, g) * (1 + scale) + shift


def in_projection(h, w_in):
    y = jnp.einsum('bld,de->ble', h, w_in)
    idx = [int(i) for i in np.cumsum(IN_SIZES)[:-1]]
    return jnp.split(y, idx, axis=-1)


def map_attention(q, k, v, coef, scale):
    m, b, h, lq, dk = q.shape
    nb = lq // Q_BLOCK
    qb = jnp.moveaxis(q.reshape(m, b, h, nb, Q_BLOCK, dk), 3, 0)

    def one(qblk):
        s = jnp.einsum('mbhqd,mbhkd->mbhqk', qblk, k, preferred_element_type=f32) * scale
        p = jnp.einsum('m,mbhqk->bhqk', coef, jax.nn.softmax(s, axis=-1))
        return jnp.einsum('bhqk,bhkv->bhqv', p.astype(v.dtype), v)

    out = lax.map(one, qb)
    return jnp.moveaxis(out, 0, 2).reshape(b, h, lq, v.shape[-1])


def mlstm_scan(q, k, v, ig, lf, state):
    b, h, l, _ = q.shape
    nc = l // M_CHUNK

    def chunks(a):
        a = a.reshape(a.shape[:2] + (nc, M_CHUNK) + a.shape[3:])
        return jnp.moveaxis(a, 2, 0)

    tri = jnp.tril(jnp.ones((M_CHUNK, M_CHUNK), dtype=bool))

    def step(carry, inp):
        c_st, n_st, m_st = carry
        qc, kc, vc, ic, fc = inp
        bcum = jnp.cumsum(fc, axis=-1)
        log_d = jnp.where(tri, bcum[..., :, None] - bcum[..., None, :] + ic[..., None, :], -jnp.inf)
        inter = bcum + m_st[..., None]
        mj = jnp.maximum(inter, jnp.max(log_d, axis=-1))
        s = jnp.einsum('bhjd,bhsd->bhjs', qc, kc) * jnp.exp(log_d - mj[..., None])
        w_inter = jnp.exp(inter - mj)
        num = jnp.einsum('bhjs,bhsv->bhjv', s, vc) + w_inter[..., None] * jnp.einsum('bhjd,bhdv->bhjv', qc, c_st)
        den = jnp.sum(s, axis=-1) + w_inter * jnp.einsum('bhjd,bhd->bhj', qc, n_st)
        hj = num / jnp.maximum(jnp.abs(den), jnp.exp(-mj))[..., None]
        b_last = bcum[..., -1]
        log_w = b_last[..., None] - bcum + ic
        m_new = jnp.maximum(b_last + m_st, jnp.max(log_w, axis=-1))
        w = jnp.exp(log_w - m_new[..., None])
        decay = jnp.exp(b_last + m_st - m_new)
        c_new = decay[..., None, None] * c_st + jnp.einsum('bhs,bhsd,bhsv->bhdv', w, kc, vc)
        n_new = decay[..., None] * n_st + jnp.einsum('bhs,bhsd->bhd', w, kc)
        return (c_new, n_new, m_new), hj

    final, hs = lax.scan(step, state, (chunks(q), chunks(k), chunks(v), chunks(ig), chunks(lf)))
    return jnp.moveaxis(hs, 0, 2).reshape(b, h, l, v.shape[-1]), final


def mlstm_inputs(mq, mk, mv, mg, gate_b):
    b, l, _ = mq.shape
    q = heads(mq, M_HEADS).astype(f32) * (M_DK ** -0.5)
    k = heads(mk, M_HEADS).astype(f32)
    v = heads(mv, M_HEADS).astype(f32)
    g = mg.astype(f32).reshape(b, l, 4, M_HEADS) + gate_b.astype(f32)
    g = GATE_SOFTCAP * jnp.tanh(g / GATE_SOFTCAP)
    return q, k, v, jnp.transpose(g, (2, 0, 3, 1))


def mlstm_bidir(q, k, v, g, state_f, state_b):
    flip = lambda a: jnp.flip(a, axis=2)
    h_f, fin_f = mlstm_scan(q, k, v, g[0], jax.nn.log_sigmoid(g[1]), state_f)
    h_b, fin_b = mlstm_scan(flip(q), flip(k), flip(v), flip(g[2]), flip(jax.nn.log_sigmoid(g[3])), state_b)
    return h_f + flip(h_b), fin_f, fin_b


def mlstm_output(hsum, o_pre, norm_g):
    _, h, _, dv = hsum.shape
    hn = rms_norm(hsum, norm_g.reshape(h, 1, dv))
    return merge_heads(hn).astype(o_pre.dtype) * jax.nn.sigmoid(o_pre)


def mla_q(cq, q_norm_g, w_uq, rope):
    q = heads(jnp.einsum('blr,re->ble', rms_norm(cq, q_norm_g), w_uq), A_HEADS)
    return jnp.concatenate([q[..., :A_NOPE], apply_rope(q[..., A_NOPE:], rope)], axis=-1)


def mla_kv(ckv, kpe, kv_norm_g, w_ukv, rope):
    kv = heads(jnp.einsum('blr,re->ble', rms_norm(ckv, kv_norm_g), w_ukv), A_HEADS)
    k_pe = apply_rope(kpe[:, None], rope)
    b, a, l, _ = kv.shape
    k = jnp.concatenate([kv[..., :A_NOPE], jnp.broadcast_to(k_pe, (b, a, l, A_ROPE))], axis=-1)
    return k, kv[..., A_NOPE:]


def diff_split(t, rope):
    t = apply_rope(heads(t, 2 * DF_HEADS), rope)
    b, _, l, d = t.shape
    return t.reshape(b, DF_HEADS, 2, l, d).transpose(2, 0, 1, 3, 4)


def diff_out(o, norm_g, lam_init):
    h = o.shape[1]
    return merge_heads(rms_norm(o, norm_g.reshape(h, 1, -1)) * (1.0 - lam_init))


def merge_branches(ym, ya, yd, gate_pre, w_branch, w_out):
    b, l, _ = ym.shape
    yb = jnp.einsum('blnw,nwd->blnd', jnp.stack([ym, ya, yd], axis=2), w_branch)
    g = jax.nn.sigmoid(gate_pre.reshape(b, l, N_BRANCH, D_MODEL))
    return jnp.einsum('bld,de->ble', jnp.sum(g * yb, axis=2), w_out)


def mixer_block(h, hc, w_in, m_gate_b, m_norm_g, q_norm_g, w_uq, kv_norm_g, w_ukv,
                diff_lam, diff_norm_g, w_branch, w_out, rope_a, rope_d, lam_init, need_ctx):
    b = h.shape[0]
    mq, mk, mv, mo, mg, cq, ckv, kpe, dq, dk, dv, gl = in_projection(h, w_in)
    mqc, mkc, mvc, moc, mgc, cqc, ckvc, kpec, dqc, dkc, dvc, glc = in_projection(hc, w_in)
    zero = (jnp.zeros((b, M_HEADS, M_DK, M_DV), f32), jnp.zeros((b, M_HEADS, M_DK), f32),
            jnp.zeros((b, M_HEADS), f32))
    hm_c, st_f, st_b = mlstm_bidir(*mlstm_inputs(mqc, mkc, mvc, mgc, m_gate_b), zero, zero)
    hm, _, _ = mlstm_bidir(*mlstm_inputs(mq, mk, mv, mg, m_gate_b), st_f, st_b)
    scale_a = (A_NOPE + A_ROPE) ** -0.5
    one = jnp.ones((1,), f32)
    ka, va = mla_kv(ckv, kpe, kv_norm_g, w_ukv, rope_a)
    kac, vac = mla_kv(ckvc, kpec, kv_norm_g, w_ukv, None)
    ya = map_attention(mla_q(cq, q_norm_g, w_uq, rope_a)[None], jnp.concatenate([ka, kac], axis=2)[None],
                       jnp.concatenate([va, vac], axis=2), one, scale_a)
    lf = diff_lam.astype(f32)
    lam = jnp.exp(jnp.sum(lf[0] * lf[1])) - jnp.exp(jnp.sum(lf[2] * lf[3])) + lam_init
    coef = jnp.stack([jnp.ones((), f32), -lam])
    scale_d = DF_DK ** -0.5
    kd, kdc = diff_split(dk, rope_d), diff_split(dkc, None)
    vd, vdc = heads(dv, DF_HEADS), heads(dvc, DF_HEADS)
    yd = map_attention(diff_split(dq, rope_d), jnp.concatenate([kd, kdc], axis=3),
                       jnp.concatenate([vd, vdc], axis=2), coef, scale_d)
    y = merge_branches(mlstm_output(hm, mo, m_norm_g), merge_heads(ya), diff_out(yd, diff_norm_g, lam_init),
                       gl, w_branch, w_out)
    if not need_ctx:
        return y, None
    ya_c = map_attention(mla_q(cqc, q_norm_g, w_uq, None)[None], kac[None], vac, one, scale_a)
    yd_c = map_attention(diff_split(dqc, None), kdc, vdc, coef, scale_d)
    yc = merge_branches(mlstm_output(hm_c, moc, m_norm_g), merge_heads(ya_c),
                        diff_out(yd_c, diff_norm_g, lam_init), glc, w_branch, w_out)
    return y, yc


def moe_ffn(h, router_w, router_b, w_gu, b_gu, w_down, b_down):
    n, d = h.shape
    logits = (h @ router_w + router_b).astype(f32)
    top_v, top_i = lax.top_k(logits, TOP_K)
    wts = jax.nn.softmax(top_v, axis=-1)
    nk = n * TOP_K
    flat_e = top_i.reshape(nk)
    flat_t = jnp.repeat(jnp.arange(n, dtype=jnp.int32), TOP_K)
    order = jnp.argsort(flat_e)
    se, st, sw = flat_e[order], flat_t[order], wts.reshape(nk)[order]
    counts = jnp.bincount(flat_e, length=N_EXPERTS)
    padded = (counts + MOE_BLOCK - 1) // MOE_BLOCK * MOE_BLOCK
    pad_end = jnp.cumsum(padded)
    grp_start = jnp.cumsum(counts) - counts
    dest = pad_end[se] - padded[se] + (jnp.arange(nk, dtype=jnp.int32) - grp_start[se])
    cap = -(-(nk + N_EXPERTS * (MOE_BLOCK - 1)) // MOE_BLOCK) * MOE_BLOCK
    n_blocks = cap // MOE_BLOCK
    slot_t = jnp.zeros((cap,), jnp.int32).at[dest].set(st)
    slot_w = jnp.zeros((cap,), f32).at[dest].set(sw)
    blk_e = jnp.minimum(jnp.searchsorted(pad_end, jnp.arange(n_blocks) * MOE_BLOCK, side='right'), N_EXPERTS - 1)
    xs = h[slot_t].reshape(n_blocks, MOE_BLOCK, d)

    def expert_block(args):
        xb, e = args
        gu = xb @ w_gu[e] + b_gu[e]
        gate = jnp.minimum(gu[:, :D_EXPERT], SWIGLU_LIMIT)
        up = jnp.clip(gu[:, D_EXPERT:], -SWIGLU_LIMIT, SWIGLU_LIMIT)
        act = (up + 1) * (gate * jax.nn.sigmoid(SWIGLU_ALPHA * gate))
        return act @ w_down[e] + b_down[e]

    ys = lax.map(expert_block, (xs, blk_e)).reshape(cap, d)
    ys = ys * slot_w[:, None].astype(ys.dtype)
    return jnp.zeros_like(h).at[slot_t].add(ys)


def setup_inputs(seed: int = 0) -> dict:
    key = jax.random.key(seed)
    ks = jax.random.split(key, 24)
    nrm = lambda k, shape, s: jax.random.normal(k, shape, f32) * s
    d = D_MODEL
    gate_off = jnp.array([0.0, 3.0, 0.0, 3.0], f32)[None, :, None]
    return {
        'x': nrm(ks[0], (BATCH, SEQ, d), 1.0),
        'c': nrm(ks[1], (BATCH, d), 1.0),
        'ctx': nrm(ks[2], (BATCH, CTX_LEN, d), 1.0),
        'c_ctx': nrm(ks[3], (d,), 1.0),
        'ada_w': nrm(ks[4], (DEPTH, d, 6 * d), 0.5 * d ** -0.5),
        'ada_b': nrm(ks[5], (DEPTH, 6 * d), 0.02),
        'norm_g': 1.0 + nrm(ks[6], (DEPTH, 4, d), 0.02),
        'w_in': nrm(ks[7], (DEPTH, d, D_IN), d ** -0.5),
        'm_gate_b': gate_off + nrm(ks[8], (DEPTH, 4, M_HEADS), 0.1),
        'm_norm_g': 1.0 + nrm(ks[9], (DEPTH, M_HEADS * M_DV), 0.02),
        'q_norm_g': 1.0 + nrm(ks[10], (DEPTH, Q_LORA), 0.02),
        'w_uq': nrm(ks[11], (DEPTH, Q_LORA, A_HEADS * (A_NOPE + A_ROPE)), Q_LORA ** -0.5),
        'kv_norm_g': 1.0 + nrm(ks[12], (DEPTH, KV_LORA), 0.02),
        'w_ukv': nrm(ks[13], (DEPTH, KV_LORA, A_HEADS * (A_NOPE + A_V)), KV_LORA ** -0.5),
        'diff_lam': nrm(ks[14], (DEPTH, 4, DF_DK), 0.1),
        'diff_norm_g': 1.0 + nrm(ks[15], (DEPTH, DF_HEADS * DF_DV), 0.02),
        'w_branch': nrm(ks[16], (DEPTH, N_BRANCH, BRANCH_W, d), BRANCH_W ** -0.5),
        'w_out': nrm(ks[17], (DEPTH, d, d), d ** -0.5),
        'router_w': nrm(ks[18], (DEPTH, d, N_EXPERTS), d ** -0.5),
        'router_b': nrm(ks[19], (DEPTH, N_EXPERTS), 0.01),
        'w_gu': nrm(ks[20], (DEPTH, N_EXPERTS, d, 2 * D_EXPERT), d ** -0.5),
        'b_gu': nrm(ks[21], (DEPTH, N_EXPERTS, 2 * D_EXPERT), 0.02),
        'w_down': nrm(ks[22], (DEPTH, N_EXPERTS, D_EXPERT, d), D_EXPERT ** -0.5),
        'b_down': nrm(ks[23], (DEPTH, N_EXPERTS, d), 0.02),
    }


def reference(x, c, ctx, c_ctx, ada_w, ada_b, norm_g, w_in, m_gate_b, m_norm_g, q_norm_g, w_uq,
              kv_norm_g, w_ukv, diff_lam, diff_norm_g, w_branch, w_out, router_w, router_b,
              w_gu, b_gu, w_down, b_down):
    n_lat = x.shape[1]
    rows = n_lat // GRID_W
    rope_a = axial_rope(rows, A_ROPE)
    rope_d = axial_rope(rows, DF_DK)
    xc = ctx
    for l in range(DEPTH):
        need_ctx = l < DEPTH - 1
        lam_init = 0.8 - 0.6 * math.exp(-0.3 * l)
        sh1, sc1, ga1, sh2, sc2, ga2 = [p[:, None, :] for p in adaln(c, ada_w[l], ada_b[l])]
        sh1c, sc1c, ga1c, sh2c, sc2c, ga2c = adaln(c_ctx, ada_w[l], ada_b[l])
        y, yc = mixer_block(modulate(x, norm_g[l, 0], sh1, sc1), modulate(xc, norm_g[l, 0], sh1c, sc1c),
                            w_in[l], m_gate_b[l], m_norm_g[l], q_norm_g[l], w_uq[l], kv_norm_g[l], w_ukv[l],
                            diff_lam[l], diff_norm_g[l], w_branch[l], w_out[l], rope_a, rope_d, lam_init, need_ctx)
        x = x + ga1 * rms_norm(y, norm_g[l, 1])
        h2 = modulate(x, norm_g[l, 2], sh2, sc2).reshape(-1, D_MODEL)
        if need_ctx:
            xc = xc + ga1c * rms_norm(yc, norm_g[l, 1])
            h2c = modulate(xc, norm_g[l, 2], sh2c, sc2c).reshape(-1, D_MODEL)
            f = moe_ffn(jnp.concatenate([h2, h2c], axis=0), router_w[l], router_b[l], w_gu[l], b_gu[l],
                        w_down[l], b_down[l])
            f_lat = f[:h2.shape[0]]
            xc = xc + ga2c * rms_norm(f[h2.shape[0]:].reshape(xc.shape), norm_g[l, 3])
        else:
            f_lat = moe_ffn(h2, router_w[l], router_b[l], w_gu[l], b_gu[l], w_down[l], b_down[l])
        x = x + ga2 * rms_norm(f_lat.reshape(x.shape), norm_g[l, 3])
    return x
```

```cpp
#include <hip/hip_runtime.h>
#include <stdint.h>

#define LAS __attribute__((address_space(3)))
typedef unsigned short bf16_t;
typedef short bf16x8 __attribute__((ext_vector_type(8)));
typedef short s16x4 __attribute__((ext_vector_type(4)));
typedef float f32x2 __attribute__((ext_vector_type(2)));
typedef float f32x4 __attribute__((ext_vector_type(4)));
typedef float f32x16 __attribute__((ext_vector_type(16)));
typedef unsigned u32x2 __attribute__((ext_vector_type(2)));
typedef unsigned u32x4 __attribute__((ext_vector_type(4)));

constexpr int DM = 1024, L = 16384, LC = 256, LT = L + LC, DEPTH = 2;
constexpr int NIN = 7088, NINP = 7168;
constexpr int C_MQ = 0, C_MK = 512, C_MV = 1024, C_MO = 1536, C_MG = 2048, C_CQ = 2064, C_CKV = 2320, C_KPE = 2448, C_DQ = 2480, C_DK = 2992, C_DV = 3504, C_GL = 4016;
constexpr int NE = 32, DE = 1024;
constexpr int NCH = LT / 64;
constexpr int CAP_TILES = 292;
constexpr float EPS = 1e-6f;
constexpr int NTHR = 512;
constexpr int LDS_BYTES = 147456;

constexpr size_t al256(size_t x) { return (x + 255) & ~(size_t)255; }
constexpr size_t WS_BAR = 0;
constexpr size_t WS_CNT = 16384;
constexpr size_t WS_TILE = WS_CNT + 1024;
constexpr size_t WS_MOD = WS_TILE + 4096;
constexpr size_t WS_W = al256(WS_MOD + (size_t)DEPTH * 2 * 6144 * 4);
constexpr size_t W_IN = 0;
constexpr size_t W_UQ = W_IN + (size_t)NINP * 1024 * 2;
constexpr size_t W_UKV = W_UQ + (size_t)768 * 256 * 2;
constexpr size_t W_BR = W_UKV + (size_t)1024 * 256 * 2;
constexpr size_t W_OUT3 = W_BR + (size_t)3072 * 512 * 2;
constexpr size_t W_GU = W_OUT3 + (size_t)1024 * 3072 * 2;
constexpr size_t W_DN = W_GU + (size_t)NE * 2048 * 1024 * 2;
constexpr size_t W_LAYER = W_DN + (size_t)NE * 1024 * 1024 * 2;
constexpr size_t WS_X = al256(WS_W + DEPTH * W_LAYER);
constexpr size_t WS_H = al256(WS_X + (size_t)LT * 1024 * 4);
constexpr size_t WS_Y = al256(WS_H + (size_t)(LT + 1) * 1024 * 2);
constexpr size_t WS_GATES = al256(WS_Y + (size_t)LT * NINP * 2);
constexpr size_t WS_CQN = al256(WS_GATES + (size_t)LT * 16 * 4);
constexpr size_t WS_CKVN = al256(WS_CQN + (size_t)LT * 256 * 2);
constexpr size_t WS_KPE = al256(WS_CKVN + (size_t)LT * 256 * 2);
constexpr size_t WS_KD = al256(WS_KPE + (size_t)LT * 32 * 2);
constexpr size_t WS_QRAW = al256(WS_KD + (size_t)LT * 1024 * 2);
constexpr size_t WS_KVRAW = al256(WS_QRAW + (size_t)LT * 768 * 2);
constexpr size_t WS_CLOC = al256(WS_KVRAW + (size_t)LT * 1024 * 2);
constexpr size_t WS_CST = al256(WS_CLOC + (size_t)8 * NCH * 16384 * 2);
constexpr size_t WS_NLOC = al256(WS_CST + (size_t)8 * NCH * 16384 * 2);
constexpr size_t WS_NST = al256(WS_NLOC + (size_t)8 * NCH * 128 * 4);
constexpr size_t WS_SCAL = al256(WS_NST + (size_t)8 * NCH * 128 * 4);
constexpr size_t WS_MST = al256(WS_SCAL + (size_t)8 * NCH * 2 * 4);
constexpr size_t WS_YM = al256(WS_MST + (size_t)8 * NCH * 4);
constexpr size_t WS_YA = al256(WS_YM + (size_t)LT * 512 * 2);
constexpr size_t WS_YD = al256(WS_YA + (size_t)LT * 512 * 2);
constexpr size_t WS_ZCAT = al256(WS_YD + (size_t)LT * 512 * 2);
constexpr size_t WS_YMIX = al256(WS_ZCAT + (size_t)LT * 3072 * 2);
constexpr size_t WS_TOPE = al256(WS_YMIX + (size_t)LT * 1024 * 4);
constexpr size_t WS_TOPW = al256(WS_TOPE + (size_t)LT * 4 * 4);
constexpr size_t WS_POS = al256(WS_TOPW + (size_t)LT * 4 * 4);
constexpr size_t WS_XS = al256(WS_POS + (size_t)LT * 4 * 4);
constexpr size_t WS_ACT = al256(WS_XS + (size_t)CAP_TILES * 256 * 1024 * 2);
constexpr size_t WS_YS = al256(WS_ACT + (size_t)CAP_TILES * 256 * 1024 * 2);
constexpr size_t WS_END = al256(WS_YS + (size_t)CAP_TILES * 256 * 1024 * 2);

struct Params {
    const float* x; const float* c; const float* ctx; const float* c_ctx; const float* ada_w; const float* ada_b; const float* norm_g; const float* w_in;
    const float* m_gate_b; const float* m_norm_g; const float* q_norm_g; const float* w_uq; const float* kv_norm_g; const float* w_ukv; const float* diff_lam;
    const float* diff_norm_g; const float* w_branch; const float* w_out; const float* router_w; const float* router_b; const float* w_gu; const float* b_gu;
    const float* w_down; const float* b_down;
    float* out; unsigned char* ws;
};

constexpr int TIDTAB_OFF = LDS_BYTES - 512;
__device__ __forceinline__ int hw_wave_slot() { return (int)(__builtin_amdgcn_s_getreg((5 << 11) | 4) & 63u); }
__device__ __forceinline__ void tid_setup() { if ((threadIdx.x & 63) == 0) ((volatile LAS int*)(uintptr_t)TIDTAB_OFF)[hw_wave_slot()] = (int)(threadIdx.x >> 6); __syncthreads(); }
__device__ __forceinline__ int tidx() {
    const int wv = ((volatile LAS int*)(uintptr_t)TIDTAB_OFF)[hw_wave_slot()];
    int ln; asm volatile("v_mbcnt_lo_u32_b32 %0, -1, 0\n\tv_mbcnt_hi_u32_b32 %0, -1, %0" : "=v"(ln));
    return (__builtin_amdgcn_readfirstlane(wv) << 6) | ln; }
typedef __bf16 bf16x2_t __attribute__((ext_vector_type(2)));
__device__ __forceinline__ unsigned cvt_pk_bf16(float lo, float hi) { const f32x2 f = {lo, hi}; const bf16x2_t v = __builtin_convertvector(f, bf16x2_t); return __builtin_bit_cast(unsigned, v); }
__device__ __forceinline__ float bf2f(bf16_t b) { return __uint_as_float(((unsigned)b) << 16); }
__device__ __forceinline__ float bflo(unsigned w) { return __uint_as_float(w << 16); }
__device__ __forceinline__ float bfhi(unsigned w) { return __uint_as_float(w & 0xffff0000u); }
__device__ __forceinline__ bf16_t f2bf(float f) { return (bf16_t)(cvt_pk_bf16(f, 0.f) & 0xffffu); }
template <int XM> __device__ __forceinline__ float swz_xor(float v) { return __int_as_float(__builtin_amdgcn_ds_swizzle(__float_as_int(v), (XM << 10) | 0x1f)); }
__device__ __forceinline__ float half_swap_add(float v) { auto rr = __builtin_amdgcn_permlane32_swap(__float_as_uint(v), __float_as_uint(v), false, false); return __uint_as_float(rr[0]) + __uint_as_float(rr[1]); }
__device__ __forceinline__ float half_swap_max(float v) { auto rr = __builtin_amdgcn_permlane32_swap(__float_as_uint(v), __float_as_uint(v), false, false); return fmaxf(__uint_as_float(rr[0]), __uint_as_float(rr[1])); }
__device__ __forceinline__ float wave_sum(float v) { v += swz_xor<16>(v); v += swz_xor<8>(v); v += swz_xor<4>(v); v += swz_xor<2>(v); v += swz_xor<1>(v); return half_swap_add(v); }
__device__ __forceinline__ float wave_max(float v) { v = fmaxf(v, swz_xor<16>(v)); v = fmaxf(v, swz_xor<8>(v)); v = fmaxf(v, swz_xor<4>(v)); v = fmaxf(v, swz_xor<2>(v)); v = fmaxf(v, swz_xor<1>(v)); return half_swap_max(v); }
__device__ __forceinline__ float lane_read(float v, int src_lane) { return __int_as_float(__builtin_amdgcn_ds_bpermute(src_lane << 2, __float_as_int(v))); }
__device__ __forceinline__ float sigmoidf_(float x) { return __builtin_amdgcn_rcpf(1.0f + __builtin_amdgcn_exp2f(-1.4426950408889634f * x)); }
__device__ __forceinline__ void sincos_rev(float ang, float& s, float& c) {
    float rev = ang * 0.15915494309189535f; rev -= floorf(rev);
    s = __builtin_amdgcn_sinf(rev); c = __builtin_amdgcn_cosf(rev);
}

#define XB_TMO      128
#define XB_XCNT(j)  (256  + 64 * (j))
#define XB_XSUB(j)  (1280 + 64 * (j))
#define XB_XGEN(j)  (2304 + 64 * (j))
#define XB_TOP      3328
#define XB_TOPGEN   3392
#define XCD_BAR_WORDS 3456
#define XB_SPIN_CAP (1u << 22)

__device__ __forceinline__ unsigned xb_ld(unsigned* p)              { return __hip_atomic_load(p, __ATOMIC_RELAXED, __HIP_MEMORY_SCOPE_AGENT); }
__device__ __forceinline__ unsigned xb_add(unsigned* p, unsigned v) { return __hip_atomic_fetch_add(p, v, __ATOMIC_RELAXED, __HIP_MEMORY_SCOPE_AGENT); }
__device__ __forceinline__ unsigned xb_xcc_id() { return (unsigned)__builtin_amdgcn_s_getreg((3 << 11) | 20) & 0xFu; }
#define XB_SPIN(cond, bar) do { unsigned _sp = 0; while (cond) { __builtin_amdgcn_s_sleep(1); \
    if ((++_sp & 255u) == 0u) { if (xb_ld(&(bar)[XB_TMO])) break; if (_sp > XB_SPIN_CAP) { atomicAdd(&(bar)[XB_TMO], 1u); break; } } } } while (0)

struct XcdBarrier { unsigned* bar; unsigned x; volatile LAS unsigned* st; };

__device__ __forceinline__ XcdBarrier xcd_barrier_post(unsigned* bar, volatile LAS unsigned* st) {
    XcdBarrier b; b.bar = bar; b.x = xb_xcc_id(); b.st = st;
    if (tidx() == 0) (void)xb_add(&bar[XB_XCNT(b.x)], 1u);
    return b;
}
__device__ __forceinline__ void xcd_barrier_complete(unsigned* bar, unsigned x, unsigned& nloc, unsigned& nx) {
    const unsigned G = gridDim.x * gridDim.y * gridDim.z;
    unsigned sum, cnt, mine, sp = 0u;
    for (;;) {
        sum = 0u; cnt = 0u; mine = 0u;
#pragma unroll
        for (unsigned j = 0; j < 16; ++j) { const unsigned c = xb_ld(&bar[XB_XCNT(j)]); sum += c; cnt += (c > 0u) ? 1u : 0u; mine = (j == x) ? c : mine; }
        if (sum == G) break;
        __builtin_amdgcn_s_sleep(1);
        if ((++sp & 255u) == 0u) { if (xb_ld(&bar[XB_TMO])) break; if (sp > XB_SPIN_CAP) { atomicAdd(&bar[XB_TMO], 1u); break; } }
    }
    nloc = mine > 0u ? mine : 1u; nx = cnt > 0u ? cnt : 1u;
}
__device__ __forceinline__ void xcd_barrier(const XcdBarrier& b) {
    asm volatile("s_waitcnt vmcnt(0)" ::: "memory");
    __syncthreads();
    if (tidx() == 0) {
        unsigned* bar = b.bar;
        __builtin_amdgcn_s_waitcnt(0);
        unsigned nloc = b.st[0], nx = b.st[1];
        if (nloc == 0u) { xcd_barrier_complete(bar, b.x, nloc, nx); b.st[0] = nloc; b.st[1] = nx; }
        const unsigned old = xb_add(&bar[XB_XSUB(b.x)], 1u);
        const unsigned gen = old / nloc;
        if (old + 1u == (gen + 1u) * nloc) {
            __builtin_amdgcn_fence(__ATOMIC_RELEASE, "agent");
            asm volatile("s_waitcnt vmcnt(0)" ::: "memory");
            const unsigned og = xb_add(&bar[XB_TOP], 1u);
            const unsigned tg = og / nx;
            if (og + 1u == (tg + 1u) * nx) xb_add(&bar[XB_TOPGEN], 1u);
            else XB_SPIN(xb_ld(&bar[XB_TOPGEN]) == tg, bar);
            __builtin_amdgcn_fence(__ATOMIC_ACQUIRE, "agent");
            xb_add(&bar[XB_XGEN(b.x)], 1u);
            asm volatile("s_waitcnt vmcnt(0)" ::: "memory");
        } else {
            XB_SPIN(xb_ld(&bar[XB_XGEN(b.x)]) == gen, bar);
            __builtin_amdgcn_fence(__ATOMIC_ACQUIRE, "agent");
            asm volatile("s_waitcnt vmcnt(0)" ::: "memory");
        }
    }
    __syncthreads();
}

namespace pg8 {
constexpr int BM = 256, BK = 64, HALF = 128, HTB = HALF * BK * 2, STAGE_BYTES = 8 * HTB, NXCD = 8, WGM = 8;
__device__ __forceinline__ int lds_byte(int r, int c) { const int st = (r >> 4) * 2 + (c >> 5), rr = r & 15, cc = c & 31, ob = rr * 64 + cc * 2; return st * 1024 + (ob ^ (((ob >> 9) & 1) << 5)); }
__device__ __forceinline__ void stage_rc(int b, int& R, int& C) { const int st = b / 1024, sb = b % 1024, swz = sb ^ (((sb >> 9) & 1) << 5); R = (st >> 1) * 16 + swz / 64; C = (st & 1) * 32 + (swz % 64) / 2; }
__device__ __forceinline__ int perm32(int rho) { const int n = rho >> 4, i = rho & 15; return 8 * (i >> 2) + 4 * n + (i & 3); }

struct Unit { int pm, pn; const char* A; const char* B; };

__device__ __forceinline__ int xcd_remap(int wgid, int nwg) { const int q = nwg / NXCD, r = nwg % NXCD, xcd = wgid % NXCD, off = wgid / NXCD; return (xcd < r ? xcd * (q + 1) : r * (q + 1) + (xcd - r) * q) + off; }

template <class Epi, class Sched>
__device__ __forceinline__ void gemm_phase(LAS unsigned char* lds, const int K, const unsigned lda, const unsigned ldb, const Sched& S, const Epi& E) {
    const int tid = tidx(), wid = __builtin_amdgcn_readfirstlane(tid >> 6), lane = tid & 63, wr = wid >> 2, wc = wid & 3, fr = lane & 15, fq = lane >> 4;
    const int nt = K / BK;
    unsigned voffA[2], voffB[2];
#pragma unroll
    for (int i = 0; i < 2; ++i) { int R, C; stage_rc(tid * 16 + i * 8192, R, C); const int Rb = Epi::PERM ? ((R & ~31) + perm32(R & 31)) : R;
        voffA[i] = (unsigned)R * lda + (unsigned)C * 2u; voffB[i] = (unsigned)Rb * ldb + (unsigned)C * 2u; }
    const size_t kstep = (size_t)(BK * 2);
    const size_t hstepA = (size_t)HALF * lda, hstepB = (size_t)HALF * ldb;
    const unsigned ldsw = (unsigned)wid * 1024u;
    const int aoff = lds_byte(wr * 64 + fr, fq * 8), boff = lds_byte(wc * 32 + fr, fq * 8);
#define PG8_SA(b, h) (((b) * 2 + (h)) * HTB)
#define PG8_SB(b, h) ((4 + (b) * 2 + (h)) * HTB)
#define PG8_STAGE(bufoff, gbase, voff) do { _Pragma("unroll") for (int _i = 0; _i < 2; ++_i) \
        __builtin_amdgcn_global_load_lds((const unsigned*)((const char*)(gbase) + (voff)[_i]), (LAS unsigned*)(lds + (bufoff) + ldsw + _i * 8192), 16, 0, 0); } while (0)
#define PG8_LDA(dst, b, h) do { _Pragma("unroll") for (int m = 0; m < 4; ++m) _Pragma("unroll") for (int k = 0; k < 2; ++k) dst[m][k] = *(const LAS bf16x8*)(lds + PG8_SA(b, h) + aoff + m * 2048 + k * 1024); } while (0)
#define PG8_LDB(dst, b, h) do { _Pragma("unroll") for (int n = 0; n < 2; ++n) _Pragma("unroll") for (int k = 0; k < 2; ++k) dst[n][k] = *(const LAS bf16x8*)(lds + PG8_SB(b, h) + boff + n * 2048 + k * 1024); } while (0)
#define PG8_MMA(ai, bj, At, Bt) do { __builtin_amdgcn_s_setprio(1); _Pragma("unroll") for (int m = 0; m < 4; ++m) _Pragma("unroll") for (int n = 0; n < 2; ++n) _Pragma("unroll") for (int k = 0; k < 2; ++k) \
        acc[ai][bj][m][n] = __builtin_amdgcn_mfma_f32_16x16x32_bf16(Bt[n][k], At[m][k], acc[ai][bj][m][n], 0, 0, 0); __builtin_amdgcn_s_setprio(0); } while (0)
#define PG8_WAIT_V(n) asm volatile("s_waitcnt vmcnt(" #n ")" ::: "memory")
#define PG8_WAIT_VE(relax) asm volatile("s_waitcnt vmcnt(%1)\n\ts_cmp_lg_u32 %0, 0\n\ts_cbranch_scc1 1f\n\ts_waitcnt vmcnt(6)\n1:" :: "s"(relax), "i"(6 + Epi::NST) : "memory", "scc")
#define PG8_WAIT_L(n) asm volatile("s_waitcnt lgkmcnt(" #n ")" ::: "memory")
#define PG8_BAR __builtin_amdgcn_s_barrier()
#define PG8_SCHED __builtin_amdgcn_sched_barrier(0)
    Unit cur, nxt; int ui = 0;
    if (!S.next(0, cur)) return;
    f32x4 acc[2][2][4][2];
#pragma unroll
    for (int a = 0; a < 2; ++a)
#pragma unroll
        for (int b = 0; b < 2; ++b)
#pragma unroll
            for (int m = 0; m < 4; ++m)
#pragma unroll
                for (int n = 0; n < 2; ++n) acc[a][b][m][n] = (f32x4){0.f, 0.f, 0.f, 0.f};
    bf16x8 At[4][2], B0[2][2], B1[2][2];
    const char* cA = cur.A; const char* cB = cur.B;
    PG8_STAGE(PG8_SB(0, 0), cB, voffB); PG8_STAGE(PG8_SA(0, 0), cA, voffA); PG8_STAGE(PG8_SB(0, 1), cB + hstepB, voffB); PG8_STAGE(PG8_SA(0, 1), cA + hstepA, voffA);
    if (wr == 1) PG8_BAR;
    PG8_WAIT_V(4); PG8_BAR;
    PG8_STAGE(PG8_SB(1, 0), cB + kstep, voffB); PG8_STAGE(PG8_SA(1, 0), cA + kstep, voffA); PG8_STAGE(PG8_SB(1, 1), cB + hstepB + kstep, voffB); PG8_STAGE(PG8_SA(1, 1), cA + kstep + hstepA, voffA);
    PG8_WAIT_V(8); PG8_BAR;
    for (;;) {
        const bool has_next = S.next(ui + 1, nxt);
        const char* nA = has_next ? nxt.A : cA; const char* nB = has_next ? nxt.B : cB;
        for (int t = 0; t < nt; t += 2) {
            const bool last = (t == nt - 2);
            const char* a2 = last ? nA : cA + (size_t)(t + 2) * kstep; const char* b2 = last ? nB : cB + (size_t)(t + 2) * kstep;
            const char* a3 = a2 + kstep; const char* b3 = b2 + kstep;
            PG8_LDB(B0, 0, 0); PG8_SCHED; PG8_LDA(At, 0, 0);
            PG8_WAIT_L(8); PG8_BAR; PG8_WAIT_L(0); PG8_MMA(0, 0, At, B0); PG8_BAR; PG8_SCHED;
            PG8_LDB(B1, 0, 1); PG8_STAGE(PG8_SB(0, 0), b2, voffB);
            PG8_BAR; PG8_WAIT_L(0); PG8_MMA(0, 1, At, B1); PG8_BAR;
            PG8_LDA(At, 0, 1); PG8_STAGE(PG8_SA(0, 0), a2, voffA);
            PG8_BAR; PG8_WAIT_L(0); PG8_MMA(1, 0, At, B0); PG8_BAR; PG8_SCHED;
            PG8_STAGE(PG8_SB(0, 1), b2 + hstepB, voffB);
            PG8_WAIT_VE(__builtin_amdgcn_readfirstlane((int)(t == 0 && ui != 0)));
            PG8_BAR; PG8_MMA(1, 1, At, B1); PG8_BAR;
            PG8_LDB(B0, 1, 0); PG8_SCHED; PG8_LDA(At, 1, 0); PG8_STAGE(PG8_SA(0, 1), a2 + hstepA, voffA);
            PG8_WAIT_L(8); PG8_BAR; PG8_WAIT_L(0); PG8_MMA(0, 0, At, B0); PG8_BAR; PG8_SCHED;
            PG8_LDB(B1, 1, 1); PG8_STAGE(PG8_SB(1, 0), b3, voffB);
            PG8_BAR; PG8_WAIT_L(0); PG8_MMA(0, 1, At, B1); PG8_BAR;
            PG8_LDA(At, 1, 1); PG8_STAGE(PG8_SA(1, 0), a3, voffA);
            PG8_BAR; PG8_WAIT_L(0); PG8_MMA(1, 0, At, B0); PG8_BAR; PG8_SCHED;
            PG8_STAGE(PG8_SB(1, 1), b3 + hstepB, voffB);
            PG8_WAIT_V(6); PG8_BAR; PG8_MMA(1, 1, At, B1); PG8_BAR;
            PG8_STAGE(PG8_SA(1, 1), a3 + hstepA, voffA);
            asm volatile("" ::: "memory");
        }
        E(acc, cur, wr, wc, fr, fq);
        if (!has_next) break;
#pragma unroll
        for (int a = 0; a < 2; ++a)
#pragma unroll
            for (int b = 0; b < 2; ++b)
#pragma unroll
                for (int m = 0; m < 4; ++m)
#pragma unroll
                    for (int n = 0; n < 2; ++n) acc[a][b][m][n] = (f32x4){0.f, 0.f, 0.f, 0.f};
        cur = nxt; cA = nA; cB = nB; ++ui;
    }
    PG8_WAIT_V(0);
    if (wr == 0) PG8_BAR;
    PG8_BAR;
#undef PG8_SA
#undef PG8_SB
#undef PG8_STAGE
#undef PG8_LDA
#undef PG8_LDB
#undef PG8_MMA
#undef PG8_WAIT_V
#undef PG8_WAIT_L
#undef PG8_WAIT_VE
#undef PG8_BAR
#undef PG8_SCHED
}

template <class Epi, class Sched>
__device__ __forceinline__ void gemm_phase_gather(LAS unsigned char* lds, const int K, const unsigned lda, const unsigned ldb, const Sched& S, const Epi& E, const char* Abase, const LAS int* lmap) {
    const int tid = tidx(), wid = __builtin_amdgcn_readfirstlane(tid >> 6), lane = tid & 63, wr = wid >> 2, wc = wid & 3, fr = lane & 15, fq = lane >> 4;
    const int nt = K / BK;
    unsigned voffB[2]; int RA[2]; unsigned CA2[2];
#pragma unroll
    for (int i = 0; i < 2; ++i) { int R, C; stage_rc(tid * 16 + i * 8192, R, C); const int Rb = Epi::PERM ? ((R & ~31) + perm32(R & 31)) : R;
        RA[i] = R; CA2[i] = (unsigned)C * 2u; voffB[i] = (unsigned)Rb * ldb + (unsigned)C * 2u; }
    unsigned gc[2][2], gn[2][2];
#define PG8_GOFF(dst, u) do { _Pragma("unroll") for (int h_ = 0; h_ < 2; ++h_) _Pragma("unroll") for (int i_ = 0; i_ < 2; ++i_) { \
        const unsigned r_ = (unsigned)lmap[(u) * 256 + h_ * 128 + RA[i_]]; dst[h_][i_] = r_ * lda + CA2[i_]; } } while (0)
#define PG8_STAGEA(bufoff, g2, kb) do { _Pragma("unroll") for (int _i = 0; _i < 2; ++_i) \
        __builtin_amdgcn_global_load_lds((const unsigned*)(Abase + (size_t)(kb) + (g2)[_i]), (LAS unsigned*)(lds + (bufoff) + ldsw + _i * 8192), 16, 0, 0); } while (0)
    const size_t kstep = (size_t)(BK * 2);
    const size_t hstepB = (size_t)HALF * ldb;
    const unsigned ldsw = (unsigned)wid * 1024u;
    const int aoff = lds_byte(wr * 64 + fr, fq * 8), boff = lds_byte(wc * 32 + fr, fq * 8);
#define PG8_SA(b, h) (((b) * 2 + (h)) * HTB)
#define PG8_SB(b, h) ((4 + (b) * 2 + (h)) * HTB)
#define PG8_STAGE(bufoff, gbase, voff) do { _Pragma("unroll") for (int _i = 0; _i < 2; ++_i) \
        __builtin_amdgcn_global_load_lds((const unsigned*)((const char*)(gbase) + (voff)[_i]), (LAS unsigned*)(lds + (bufoff) + ldsw + _i * 8192), 16, 0, 0); } while (0)
#define PG8_LDA(dst, b, h) do { _Pragma("unroll") for (int m = 0; m < 4; ++m) _Pragma("unroll") for (int k = 0; k < 2; ++k) dst[m][k] = *(const LAS bf16x8*)(lds + PG8_SA(b, h) + aoff + m * 2048 + k * 1024); } while (0)
#define PG8_LDB(dst, b, h) do { _Pragma("unroll") for (int n = 0; n < 2; ++n) _Pragma("unroll") for (int k = 0; k < 2; ++k) dst[n][k] = *(const LAS bf16x8*)(lds + PG8_SB(b, h) + boff + n * 2048 + k * 1024); } while (0)
#define PG8_MMA(ai, bj, At, Bt) do { __builtin_amdgcn_s_setprio(1); _Pragma("unroll") for (int m = 0; m < 4; ++m) _Pragma("unroll") for (int n = 0; n < 2; ++n) _Pragma("unroll") for (int k = 0; k < 2; ++k) \
        acc[ai][bj][m][n] = __builtin_amdgcn_mfma_f32_16x16x32_bf16(Bt[n][k], At[m][k], acc[ai][bj][m][n], 0, 0, 0); __builtin_amdgcn_s_setprio(0); } while (0)
#define PG8_WAIT_V(n) asm volatile("s_waitcnt vmcnt(" #n ")" ::: "memory")
#define PG8_WAIT_VE(relax) asm volatile("s_waitcnt vmcnt(%1)\n\ts_cmp_lg_u32 %0, 0\n\ts_cbranch_scc1 1f\n\ts_waitcnt vmcnt(6)\n1:" :: "s"(relax), "i"(6 + Epi::NST) : "memory", "scc")
#define PG8_WAIT_L(n) asm volatile("s_waitcnt lgkmcnt(" #n ")" ::: "memory")
#define PG8_BAR __builtin_amdgcn_s_barrier()
#define PG8_SCHED __builtin_amdgcn_sched_barrier(0)
    Unit cur, nxt; int ui = 0;
    if (!S.next(0, cur)) return;
    f32x4 acc[2][2][4][2];
#pragma unroll
    for (int a = 0; a < 2; ++a)
#pragma unroll
        for (int b = 0; b < 2; ++b)
#pragma unroll
            for (int m = 0; m < 4; ++m)
#pragma unroll
                for (int n = 0; n < 2; ++n) acc[a][b][m][n] = (f32x4){0.f, 0.f, 0.f, 0.f};
    bf16x8 At[4][2], B0[2][2], B1[2][2];
    const char* cB = cur.B; PG8_GOFF(gc, 0);
    PG8_STAGE(PG8_SB(0, 0), cB, voffB); PG8_STAGEA(PG8_SA(0, 0), gc[0], 0); PG8_STAGE(PG8_SB(0, 1), cB + hstepB, voffB); PG8_STAGEA(PG8_SA(0, 1), gc[1], 0);
    if (wr == 1) PG8_BAR;
    PG8_WAIT_V(4); PG8_BAR;
    PG8_STAGE(PG8_SB(1, 0), cB + kstep, voffB); PG8_STAGEA(PG8_SA(1, 0), gc[0], kstep); PG8_STAGE(PG8_SB(1, 1), cB + hstepB + kstep, voffB); PG8_STAGEA(PG8_SA(1, 1), gc[1], kstep);
    PG8_WAIT_V(8); PG8_BAR;
    for (;;) {
        const bool has_next = S.next(ui + 1, nxt);
        const char* nB = has_next ? nxt.B : cB;
        if (has_next) PG8_GOFF(gn, ui + 1); else { gn[0][0] = gc[0][0]; gn[0][1] = gc[0][1]; gn[1][0] = gc[1][0]; gn[1][1] = gc[1][1]; }
        for (int t = 0; t < nt; t += 2) {
            const bool last = (t == nt - 2);
            const size_t ka2 = last ? (size_t)0 : (size_t)(t + 2) * kstep, ka3 = ka2 + kstep;
            unsigned g2[2][2];
#pragma unroll
            for (int h_ = 0; h_ < 2; ++h_)
#pragma unroll
                for (int i_ = 0; i_ < 2; ++i_) g2[h_][i_] = last ? gn[h_][i_] : gc[h_][i_];
            const char* b2 = last ? nB : cB + (size_t)(t + 2) * kstep; const char* b3 = b2 + kstep;
            PG8_LDB(B0, 0, 0); PG8_SCHED; PG8_LDA(At, 0, 0);
            PG8_WAIT_L(8); PG8_BAR; PG8_WAIT_L(0); PG8_MMA(0, 0, At, B0); PG8_BAR; PG8_SCHED;
            PG8_LDB(B1, 0, 1); PG8_STAGE(PG8_SB(0, 0), b2, voffB);
            PG8_BAR; PG8_WAIT_L(0); PG8_MMA(0, 1, At, B1); PG8_BAR;
            PG8_LDA(At, 0, 1); PG8_STAGEA(PG8_SA(0, 0), g2[0], ka2);
            PG8_BAR; PG8_WAIT_L(0); PG8_MMA(1, 0, At, B0); PG8_BAR; PG8_SCHED;
            PG8_STAGE(PG8_SB(0, 1), b2 + hstepB, voffB);
            PG8_WAIT_VE(__builtin_amdgcn_readfirstlane((int)(t == 0 && ui != 0)));
            PG8_BAR; PG8_MMA(1, 1, At, B1); PG8_BAR;
            PG8_LDB(B0, 1, 0); PG8_SCHED; PG8_LDA(At, 1, 0); PG8_STAGEA(PG8_SA(0, 1), g2[1], ka2);
            PG8_WAIT_L(8); PG8_BAR; PG8_WAIT_L(0); PG8_MMA(0, 0, At, B0); PG8_BAR; PG8_SCHED;
            PG8_LDB(B1, 1, 1); PG8_STAGE(PG8_SB(1, 0), b3, voffB);
            PG8_BAR; PG8_WAIT_L(0); PG8_MMA(0, 1, At, B1); PG8_BAR;
            PG8_LDA(At, 1, 1); PG8_STAGEA(PG8_SA(1, 0), g2[0], ka3);
            PG8_BAR; PG8_WAIT_L(0); PG8_MMA(1, 0, At, B0); PG8_BAR; PG8_SCHED;
            PG8_STAGE(PG8_SB(1, 1), b3 + hstepB, voffB);
            PG8_WAIT_V(6); PG8_BAR; PG8_MMA(1, 1, At, B1); PG8_BAR;
            PG8_STAGEA(PG8_SA(1, 1), g2[1], ka3);
            asm volatile("" ::: "memory");
        }
        E(acc, cur, wr, wc, fr, fq);
        if (!has_next) break;
#pragma unroll
        for (int a = 0; a < 2; ++a)
#pragma unroll
            for (int b = 0; b < 2; ++b)
#pragma unroll
                for (int m = 0; m < 4; ++m)
#pragma unroll
                    for (int n = 0; n < 2; ++n) acc[a][b][m][n] = (f32x4){0.f, 0.f, 0.f, 0.f};
        cur = nxt; cB = nB; ++ui; gc[0][0] = gn[0][0]; gc[0][1] = gn[0][1]; gc[1][0] = gn[1][0]; gc[1][1] = gn[1][1];
    }
    PG8_WAIT_V(0);
    if (wr == 0) PG8_BAR;
    PG8_BAR;
#undef PG8_SA
#undef PG8_SB
#undef PG8_STAGE
#undef PG8_STAGEA
#undef PG8_GOFF
#undef PG8_LDA
#undef PG8_LDB
#undef PG8_MMA
#undef PG8_WAIT_V
#undef PG8_WAIT_L
#undef PG8_WAIT_VE
#undef PG8_BAR
#undef PG8_SCHED
}

struct DenseOrder {
    int nM, nN, nwg, G, c, ashift; const char* A0; size_t astride; const char* B; unsigned lda, ldb;
    __device__ __forceinline__ bool next(int i, Unit& u) const {
        const long Lx = (long)i * G + c; if (Lx >= nwg) return false;
        const int wgid = xcd_remap((int)Lx, nwg);
        const int nig = WGM * nN, gid = wgid / nig, fm = gid * WGM, gsz = (nM - fm) < WGM ? (nM - fm) : WGM;
        u.pm = fm + ((wgid % nig) % gsz); u.pn = (wgid % nig) / gsz;
        const char* Ab = A0 + (size_t)(u.pn >> ashift) * astride;
        u.A = Ab + (size_t)u.pm * BM * lda; u.B = B + (size_t)u.pn * BM * ldb; return true;
    }
};
struct MoeOrder {
    int ntiles, nN, nwg, G, c; const LAS int* tile_e; const char* A; const char* B; unsigned lda, ldb; size_t bstride;
    __device__ __forceinline__ int pm_of(int i) const { const long Lx = (long)i * G + c; if (Lx >= nwg) return -1; return xcd_remap((int)Lx, nwg) / nN; }
    __device__ __forceinline__ bool next(int i, Unit& u) const {
        const long Lx = (long)i * G + c; if (Lx >= nwg) return false;
        const int wgid = xcd_remap((int)Lx, nwg);
        u.pm = wgid / nN; u.pn = wgid % nN;
        const int e = tile_e[u.pm];
        u.A = A + (size_t)u.pm * BM * lda; u.B = B + (size_t)e * bstride + (size_t)u.pn * BM * ldb; return true;
    }
};

struct EpiBf16 {
    static constexpr bool PERM = true; static constexpr int NST = 16;
    bf16_t* O; int ldc;
    __device__ __forceinline__ void operator()(const f32x4 (&acc)[2][2][4][2], const Unit& u, int wr, int wc, int fr, int fq) const {
        const int row0 = u.pm * BM + wr * 64 + fr, col0 = u.pn * BM + wc * 32 + 8 * fq;
#pragma unroll
        for (int ai = 0; ai < 2; ++ai)
#pragma unroll
            for (int m = 0; m < 4; ++m) { bf16_t* rowp = O + (size_t)(row0 + ai * HALF + m * 16) * ldc + col0;
#pragma unroll
                for (int bj = 0; bj < 2; ++bj) { const f32x4 v0 = acc[ai][bj][m][0], v1 = acc[ai][bj][m][1];
                    u32x4 w; w.x = cvt_pk_bf16(v0[0], v0[1]); w.y = cvt_pk_bf16(v0[2], v0[3]); w.z = cvt_pk_bf16(v1[0], v1[1]); w.w = cvt_pk_bf16(v1[2], v1[3]);
                    *(u32x4*)(rowp + bj * HALF) = w; } }
    }
};
struct EpiBf16HM {
    static constexpr bool PERM = true; static constexpr int NST = 16;
    bf16_t* O;
    __device__ __forceinline__ void operator()(const f32x4 (&acc)[2][2][4][2], const Unit& u, int wr, int wc, int fr, int fq) const {
        const int row0 = u.pm * BM + wr * 64 + fr, cl = wc * 32 + 8 * fq;
#pragma unroll
        for (int ai = 0; ai < 2; ++ai)
#pragma unroll
            for (int m = 0; m < 4; ++m) {
#pragma unroll
                for (int bj = 0; bj < 2; ++bj) { const f32x4 v0 = acc[ai][bj][m][0], v1 = acc[ai][bj][m][1];
                    u32x4 w; w.x = cvt_pk_bf16(v0[0], v0[1]); w.y = cvt_pk_bf16(v0[2], v0[3]); w.z = cvt_pk_bf16(v1[0], v1[1]); w.w = cvt_pk_bf16(v1[2], v1[3]);
                    *(u32x4*)(O + ((size_t)(u.pn * 2 + bj) * LT + (size_t)(row0 + ai * HALF + m * 16)) * 128 + cl) = w; } }
    }
};
struct EpiGate {
    static constexpr bool PERM = true; static constexpr int NST = 16;
    bf16_t* O; int ldc; const bf16_t* Gt; int ldg;
    __device__ __forceinline__ void operator()(const f32x4 (&acc)[2][2][4][2], const Unit& u, int wr, int wc, int fr, int fq) const {
        const int br = u.pn >> 2, pnz = u.pn & 3;
        const int row0 = u.pm * BM + wr * 64 + fr, colz = pnz * BM + wc * 32 + 8 * fq, colg = br * 1024 + colz;
#pragma unroll
        for (int ai = 0; ai < 2; ++ai) {
            u32x4 g[4][2], p[4][2];
#pragma unroll
            for (int m = 0; m < 4; ++m) { const size_t r = (size_t)(row0 + ai * HALF + m * 16);
#pragma unroll
                for (int bj = 0; bj < 2; ++bj) { g[m][bj] = *(const u32x4*)(Gt + r * ldg + colg + bj * HALF); p[m][bj] = (br != 0) ? *(const u32x4*)(O + r * ldc + colz + bj * HALF) : (u32x4){0u, 0u, 0u, 0u}; } }
#pragma unroll
            for (int m = 0; m < 4; ++m) { const size_t r = (size_t)(row0 + ai * HALF + m * 16); bf16_t* rowp = O + r * ldc + colz;
#pragma unroll
                for (int bj = 0; bj < 2; ++bj) { const f32x4 v0 = acc[ai][bj][m][0], v1 = acc[ai][bj][m][1]; const u32x4 gg = g[m][bj], pp = p[m][bj];
                    const float z0 = v0[0] * sigmoidf_(bflo(gg.x)) + bflo(pp.x), z1 = v0[1] * sigmoidf_(bfhi(gg.x)) + bfhi(pp.x), z2 = v0[2] * sigmoidf_(bflo(gg.y)) + bflo(pp.y), z3 = v0[3] * sigmoidf_(bfhi(gg.y)) + bfhi(pp.y);
                    const float z4 = v1[0] * sigmoidf_(bflo(gg.z)) + bflo(pp.z), z5 = v1[1] * sigmoidf_(bfhi(gg.z)) + bfhi(pp.z), z6 = v1[2] * sigmoidf_(bflo(gg.w)) + bflo(pp.w), z7 = v1[3] * sigmoidf_(bfhi(gg.w)) + bfhi(pp.w);
                    u32x4 w; w.x = cvt_pk_bf16(z0, z1); w.y = cvt_pk_bf16(z2, z3); w.z = cvt_pk_bf16(z4, z5); w.w = cvt_pk_bf16(z6, z7);
                    *(u32x4*)(rowp + bj * HALF) = w; } } }
    }
};
struct MergeOrder {
    int nM, nsu, G, c; const char* A0; size_t astride; const char* B; unsigned lda, ldb;
    __device__ __forceinline__ bool next(int i, Unit& u) const {
        const int su = (i / 3) * G + c, br = i % 3; if (su >= nsu) return false;
        const int s2 = xcd_remap(su, nsu);
        u.pm = s2 >> 2; const int pnz = s2 & 3; u.pn = br * 4 + pnz;
        u.A = A0 + (size_t)br * astride + (size_t)u.pm * BM * lda; u.B = B + (size_t)u.pn * BM * ldb; return true;
    }
};
struct EpiF32 {
    static constexpr bool PERM = false; static constexpr int NST = 32;
    float* C; int ldc;
    __device__ __forceinline__ void operator()(const f32x4 (&acc)[2][2][4][2], const Unit& u, int wr, int wc, int fr, int fq) const {
        const int row0 = u.pm * BM + wr * 64 + fr, col0 = u.pn * BM + wc * 32 + 4 * fq;
#pragma unroll
        for (int ai = 0; ai < 2; ++ai)
#pragma unroll
            for (int m = 0; m < 4; ++m) { float* rowp = C + (size_t)(row0 + ai * HALF + m * 16) * ldc + col0;
#pragma unroll
                for (int bj = 0; bj < 2; ++bj)
#pragma unroll
                    for (int n = 0; n < 2; ++n) *(f32x4*)(rowp + bj * HALF + n * 16) = acc[ai][bj][m][n]; }
    }
};
struct EpiSwiglu {
    static constexpr bool PERM = true; static constexpr int NST = 8;
    bf16_t* O; const float* bgu; const LAS int* tile_e;
    __device__ __forceinline__ void operator()(const f32x4 (&acc)[2][2][4][2], const Unit& u, int wr, int wc, int fr, int fq) const {
        const int row0 = u.pm * BM + wr * 64 + fr, cl = wc * 32 + 8 * fq, hc = u.pn * 128 + cl;
        const float* bb = bgu + (size_t)tile_e[u.pm] * 2048 + hc;
        const f32x4 bg0 = *(const f32x4*)(bb), bg1 = *(const f32x4*)(bb + 4), bu0 = *(const f32x4*)(bb + 1024), bu1 = *(const f32x4*)(bb + 1028);
#pragma unroll
        for (int ai = 0; ai < 2; ++ai)
#pragma unroll
            for (int m = 0; m < 4; ++m) { bf16_t* rowp = O + (size_t)(row0 + ai * HALF + m * 16) * 1024 + hc;
                float a[8];
#pragma unroll
                for (int n = 0; n < 2; ++n)
#pragma unroll
                    for (int j = 0; j < 4; ++j) { const float gt = fminf(acc[ai][0][m][n][j] + (n ? bg1[j] : bg0[j]), 7.0f);
                        const float up = fminf(fmaxf(acc[ai][1][m][n][j] + (n ? bu1[j] : bu0[j]), -7.0f), 7.0f);
                        a[n * 4 + j] = (up + 1.0f) * (gt * sigmoidf_(1.702f * gt)); }
                u32x4 w; w.x = cvt_pk_bf16(a[0], a[1]); w.y = cvt_pk_bf16(a[2], a[3]); w.z = cvt_pk_bf16(a[4], a[5]); w.w = cvt_pk_bf16(a[6], a[7]);
                *(u32x4*)rowp = w; }
    }
};
struct EpiDown {
    static constexpr bool PERM = true; static constexpr int NST = 16;
    bf16_t* O; const float* bd; const LAS int* tile_e;
    __device__ __forceinline__ void operator()(const f32x4 (&acc)[2][2][4][2], const Unit& u, int wr, int wc, int fr, int fq) const {
        const int row0 = u.pm * BM + wr * 64 + fr, col0 = u.pn * BM + wc * 32 + 8 * fq;
        const float* bb = bd + (size_t)tile_e[u.pm] * 1024 + col0;
        f32x4 bv[2][2];
#pragma unroll
        for (int bj = 0; bj < 2; ++bj)
#pragma unroll
            for (int n = 0; n < 2; ++n) bv[bj][n] = *(const f32x4*)(bb + bj * HALF + 4 * n);
#pragma unroll
        for (int ai = 0; ai < 2; ++ai)
#pragma unroll
            for (int m = 0; m < 4; ++m) { bf16_t* rowp = O + (size_t)(row0 + ai * HALF + m * 16) * 1024 + col0;
#pragma unroll
                for (int bj = 0; bj < 2; ++bj) { const f32x4 v0 = acc[ai][bj][m][0] + bv[bj][0], v1 = acc[ai][bj][m][1] + bv[bj][1];
                    u32x4 w; w.x = cvt_pk_bf16(v0[0], v0[1]); w.y = cvt_pk_bf16(v0[2], v0[3]); w.z = cvt_pk_bf16(v1[0], v1[1]); w.w = cvt_pk_bf16(v1[2], v1[3]);
                    *(u32x4*)(rowp + bj * HALF) = w; } }
    }
};
}
typedef __attribute__((address_space(1))) unsigned char gu8_t;
__device__ __forceinline__ unsigned char* wsbase(const Params& P) { unsigned long long v = (unsigned long long)P.ws; asm volatile("" : "+s"(v)); return (unsigned char*)(gu8_t*)v; }
#define WSP(T, off) ((T*)(wsbase(P) + (off)))
__device__ __forceinline__ const float* mod_ptr(const Params& P, int layer, int set) { return WSP(const float, WS_MOD) + ((size_t)layer * 2 + set) * 6144; }
__device__ __forceinline__ unsigned char* wlayer(const Params& P, int layer) { return wsbase(P) + WS_W + (size_t)layer * W_LAYER; }

__device__ __forceinline__ void adaln_item(const Params& P, int item, char* shm) {
    const int layer = item / 96, cg = item % 96, tid = tidx(), wid = tid >> 6, lane = tid & 63, col = cg * 64 + lane;
    const float* W = P.ada_w + (size_t)layer * 1024 * 6144 + col;
    float a0 = 0.f, a1 = 0.f;
#pragma unroll 8
    for (int k = wid * 128; k < wid * 128 + 128; ++k) {
        const float w = W[(size_t)k * 6144];
        const float c0 = P.c[k], c1 = P.c_ctx[k];
        a0 += (c0 / (1.0f + __expf(-c0))) * w; a1 += (c1 / (1.0f + __expf(-c1))) * w;
    }
    float* red = (float*)shm;
    red[(wid * 2 + 0) * 64 + lane] = a0; red[(wid * 2 + 1) * 64 + lane] = a1;
    __syncthreads();
    if (tid < 128) { const int set = tid >> 6; float s = 0.f;
#pragma unroll
        for (int w = 0; w < 8; ++w) s += red[(w * 2 + set) * 64 + lane];
        WSP(float, WS_MOD)[((size_t)layer * 2 + set) * 6144 + col] = s + P.ada_b[(size_t)layer * 6144 + col]; }
    __syncthreads();
}

struct ConvJob { const float* src; int srcK, srcN, ldsrc; bf16_t* dst; int lddst; int kind; };
__device__ __forceinline__ void conv_load(const ConvJob& J, int gk, int tn, int tid, f32x4 (&v)[8]) {
    const int k0 = gk * 256, n0 = tn * 64, r = tid >> 4, c = (tid & 15) * 4; const bool nok = (n0 + c) < J.srcN;
#pragma unroll
    for (int q = 0; q < 8; ++q) { const int k = k0 + r + 32 * q; v[q] = (f32x4){0.f, 0.f, 0.f, 0.f};
        if (nok && k < J.srcK) v[q] = *(const f32x4*)(J.src + (size_t)k * J.ldsrc + n0 + c); }
}
__device__ __forceinline__ void conv_store(const ConvJob& J, int gk, int tn, int tid, const f32x4 (&v)[8], char* shm) {
    float* tile = (float*)shm;
    const int k0 = gk * 256, n0 = tn * 64;
    { const int r = tid >> 4, c = (tid & 15) * 4;
#pragma unroll
      for (int q = 0; q < 8; ++q) { float* t = tile + (r + 32 * q) * 65 + c; t[0] = v[q][0]; t[1] = v[q][1]; t[2] = v[q][2]; t[3] = v[q][3]; } }
    __syncthreads();
    {
        const int nl = tid >> 3, n = n0 + nl; int drow = n; float sc = 1.0f;
        if (J.kind == 0) { if (n < 512) sc = 0.08838834764831845f; }
        if (J.kind == 5) { drow = (n < 1024) ? ((n >> 7) * 256 + (n & 127)) : (((n - 1024) >> 7) * 256 + 128 + ((n - 1024) & 127)); }
#pragma unroll
        for (int q = 0; q < 4; ++q) { const int kc = (tid & 7) * 8 + 64 * q; float w8[8];
#pragma unroll
            for (int j = 0; j < 8; ++j) w8[j] = tile[(kc + j) * 65 + nl] * sc;
            u32x4 w; w.x = cvt_pk_bf16(w8[0], w8[1]); w.y = cvt_pk_bf16(w8[2], w8[3]); w.z = cvt_pk_bf16(w8[4], w8[5]); w.w = cvt_pk_bf16(w8[6], w8[7]);
            bf16_t* d = J.dst + (size_t)drow * J.lddst + k0 + kc;
            *(u32x4*)d = w;
            if (J.kind == 4) { *(u32x4*)(d + 1024) = w; *(u32x4*)(d + 2048) = w; } }
    }
    __syncthreads();
}
__device__ __forceinline__ bool conv_lookup(const Params& P, int layer, long t, ConvJob& J, int& gk, int& tn) {
    unsigned char* wl = wlayer(P, layer);
    { const int GK = 4, TN = 112; const long n = (long)GK * TN; if (t < n) { J = ConvJob{P.w_in + (size_t)layer * 1024 * NIN, 1024, NIN, NIN, (bf16_t*)(wl + W_IN), 1024, 0}; gk = (int)(t % GK); tn = (int)(t / GK); return true; } t -= n; }
    { const int GK = 1, TN = 12; const long n = (long)GK * TN; if (t < n) { J = ConvJob{P.w_uq + (size_t)layer * 256 * 768, 256, 768, 768, (bf16_t*)(wl + W_UQ), 256, 1}; gk = (int)(t % GK); tn = (int)(t / GK); return true; } t -= n; }
    { const int GK = 1, TN = 16; const long n = (long)GK * TN; if (t < n) { J = ConvJob{P.w_ukv + (size_t)layer * 128 * 1024, 128, 1024, 1024, (bf16_t*)(wl + W_UKV), 256, 2}; gk = (int)(t % GK); tn = (int)(t / GK); return true; } t -= n; }
    { const int GK = 2, TN = 16; const long n = (long)GK * TN * 3; if (t < n) { const int b = (int)(t / (GK * TN)); const long tt = t % (GK * TN);
        J = ConvJob{P.w_branch + ((size_t)layer * 3 + b) * 512 * 1024, 512, 1024, 1024, (bf16_t*)(wl + W_BR) + (size_t)b * 1024 * 512, 512, 3}; gk = (int)(tt % GK); tn = (int)(tt / GK); return true; } t -= n; }
    { const int GK = 4, TN = 16; const long n = (long)GK * TN; if (t < n) { J = ConvJob{P.w_out + (size_t)layer * 1024 * 1024, 1024, 1024, 1024, (bf16_t*)(wl + W_OUT3), 3072, 4}; gk = (int)(t % GK); tn = (int)(t / GK); return true; } t -= n; }
    { const int GK = 4, TN = 32; const long n = (long)GK * TN * NE; if (t < n) { const int e = (int)(t / (GK * TN)); const long tt = t % (GK * TN);
        J = ConvJob{P.w_gu + ((size_t)layer * NE + e) * 1024 * 2048, 1024, 2048, 2048, (bf16_t*)(wl + W_GU) + (size_t)e * 2048 * 1024, 1024, 5}; gk = (int)(tt % GK); tn = (int)(tt / GK); return true; } t -= n; }
    { const int GK = 4, TN = 16; const long n = (long)GK * TN * NE; if (t < n) { const int e = (int)(t / (GK * TN)); const long tt = t % (GK * TN);
        J = ConvJob{P.w_down + ((size_t)layer * NE + e) * 1024 * 1024, 1024, 1024, 1024, (bf16_t*)(wl + W_DN) + (size_t)e * 1024 * 1024, 1024, 6}; gk = (int)(tt % GK); tn = (int)(tt / GK); return true; } t -= n; }
    return false;
}
constexpr long CONV_GROUPS = 4L * 112 + 12 + 16 + 96 + 64 + 128L * 32 + 64L * 32;

__device__ __forceinline__ void phase_p0(const Params& P, char* shm) {
    const int G = gridDim.x, b = blockIdx.x;
    if (b == 0 && tidx() < 256) { WSP(int, WS_CNT)[tidx()] = 0; }
    if (b == 1 && tidx() < 128) { ((u32x4*)(WSP(bf16_t, WS_H) + (size_t)LT * 1024))[tidx()] = (u32x4){0u, 0u, 0u, 0u}; }
    for (int it = b; it < 192; it += G) adaln_item(P, it, shm);
    {
        const int tid = tidx(); const long NG = CONV_GROUPS;
        ConvJob Jc, Jn; int gkc = 0, tnc = 0, gkn = 0, tnn = 0; f32x4 vc[8], vn[8];
        long t = b; bool have = t < NG;
        if (have) { (void)conv_lookup(P, (int)(t / CONV_GROUPS), t % CONV_GROUPS, Jc, gkc, tnc); conv_load(Jc, gkc, tnc, tid, vc); }
        while (have) {
            const long t2 = t + G; const bool hn = t2 < NG;
            if (hn) { (void)conv_lookup(P, (int)(t2 / CONV_GROUPS), t2 % CONV_GROUPS, Jn, gkn, tnn); conv_load(Jn, gkn, tnn, tid, vn); }
            conv_store(Jc, gkc, tnc, tid, vc, shm);
            if (hn) { Jc = Jn; gkc = gkn; tnc = tnn;
#pragma unroll
                for (int q = 0; q < 8; ++q) vc[q] = vn[q]; }
            t = t2; have = hn;
        }
    }
}

constexpr int CQ_WORD = 200;
__device__ __forceinline__ void conv_pull(const Params& P, char* shm, int quota) {
    const int tid = tidx(); int* head = WSP(int, WS_CNT) + CQ_WORD; int* slot = (int*)(shm + 70000);
    const long NG = (long)(DEPTH - 1) * CONV_GROUPS;
    for (int n = 0; quota < 0 || n < quota; ++n) {
        if (tid == 0) *slot = atomicAdd(head, 1);
        __syncthreads();
        const long t = *slot;
        __syncthreads();
        if (t >= NG) break;
        ConvJob J; int gk, tn; f32x4 v[8];
        (void)conv_lookup(P, 1 + (int)(t / CONV_GROUPS), t % CONV_GROUPS, J, gk, tn);
        conv_load(J, gk, tn, tid, v); conv_store(J, gk, tn, tid, v, shm);
    }
}
__device__ __forceinline__ int units_of(int nwg, int G, int c) { return c < nwg ? (nwg - c + G - 1) / G : 0; }

__device__ __forceinline__ const float* xrow_in(const Params& P, int layer, int r) {
    if (layer == 0) return r < L ? P.x + (size_t)r * 1024 : P.ctx + (size_t)(r - L) * 1024;
    return WSP(const float, WS_X) + (size_t)r * 1024;
}

__device__ __forceinline__ void phase_modulate1(const Params& P, int layer) {
    const int lane = tidx() & 63, gw = blockIdx.x * 8 + (tidx() >> 6), nw = gridDim.x * 8;
    const float* g0 = P.norm_g + ((size_t)layer * 4 + 0) * 1024;
    bf16_t* H = WSP(bf16_t, WS_H);
    for (int r = gw; r < LT; r += nw) {
        const float* xr = xrow_in(P, layer, r); const float* md = mod_ptr(P, layer, r < L ? 0 : 1);
        f32x4 v[4]; float ss = 0.f;
#pragma unroll
        for (int i = 0; i < 4; ++i) { v[i] = *(const f32x4*)(xr + i * 256 + lane * 4); ss += v[i][0] * v[i][0] + v[i][1] * v[i][1] + v[i][2] * v[i][2] + v[i][3] * v[i][3]; }
        ss = wave_sum(ss); const float rs = rsqrtf(ss * (1.0f / 1024.0f) + EPS);
#pragma unroll
        for (int i = 0; i < 4; ++i) { const int c = i * 256 + lane * 4; const f32x4 g = *(const f32x4*)(g0 + c), sh = *(const f32x4*)(md + c), sc = *(const f32x4*)(md + 1024 + c);
            float o[4];
#pragma unroll
            for (int j = 0; j < 4; ++j) o[j] = v[i][j] * rs * g[j] * (1.0f + sc[j]) + sh[j];
            u32x2 w; w.x = cvt_pk_bf16(o[0], o[1]); w.y = cvt_pk_bf16(o[2], o[3]); *(u32x2*)(H + (size_t)r * 1024 + c) = w; }
    }
}

__device__ __forceinline__ void phase_prep(const Params& P, int layer) {
    const int lane = tidx() & 63, gw = blockIdx.x * 8 + (tidx() >> 6), nw = gridDim.x * 8;
    const bf16_t* Y = WSP(const bf16_t, WS_Y);
    float* GT = WSP(float, WS_GATES); bf16_t* CQN = WSP(bf16_t, WS_CQN); bf16_t* CKVN = WSP(bf16_t, WS_CKVN); bf16_t* KPE = WSP(bf16_t, WS_KPE); bf16_t* KD = WSP(bf16_t, WS_KD);
    const float* qg = P.q_norm_g + (size_t)layer * 256; const float* kg = P.kv_norm_g + (size_t)layer * 128; const float* gb = P.m_gate_b + (size_t)layer * 16;
    for (int r = gw; r < LT; r += nw) {
        const bf16_t* y = Y + (size_t)r * NINP;
        const bool lat = r < L; const float prow = (float)(r >> 6), pcol = (float)(r & 63);
        if (lane < 16) { float g = bf2f(y[C_MG + lane]) + gb[lane];
            { const float e2 = __builtin_amdgcn_exp2f(g * (2.0f / 15.0f * 1.4426950408889634f)); g = 15.0f * (1.0f - 2.0f * __builtin_amdgcn_rcpf(e2 + 1.0f)); }
            const int type = lane >> 2; if (type & 1) g = fminf(g, 0.f) - __logf(1.0f + __expf(-fabsf(g)));
            GT[(size_t)r * 16 + lane] = g; }
        { const u32x2 w = *(const u32x2*)(y + C_CQ + lane * 4); float v[4] = {bflo(w.x), bfhi(w.x), bflo(w.y), bfhi(w.y)};
          float ss = v[0] * v[0] + v[1] * v[1] + v[2] * v[2] + v[3] * v[3]; ss = wave_sum(ss); const float rs = rsqrtf(ss * (1.0f / 256.0f) + EPS);
          const f32x4 g = *(const f32x4*)(qg + lane * 4); u32x2 o; o.x = cvt_pk_bf16(v[0] * rs * g[0], v[1] * rs * g[1]); o.y = cvt_pk_bf16(v[2] * rs * g[2], v[3] * rs * g[3]);
          *(u32x2*)(CQN + (size_t)r * 256 + lane * 4) = o; }
        { const unsigned w = *(const unsigned*)(y + C_CKV + lane * 2); float v0 = bflo(w), v1 = bfhi(w);
          float ss = v0 * v0 + v1 * v1; ss = wave_sum(ss); const float rs = rsqrtf(ss * (1.0f / 128.0f) + EPS);
          const f32x2 g = *(const f32x2*)(kg + lane * 2);
          *(unsigned*)(CKVN + (size_t)r * 256 + lane * 2) = cvt_pk_bf16(v0 * rs * g[0], v1 * rs * g[1]);
          *(unsigned*)(CKVN + (size_t)r * 256 + 128 + lane * 2) = 0u; }
        if (lane < 16) { const float x1 = bf2f(y[C_KPE + lane]), x2 = bf2f(y[C_KPE + 16 + lane]); float o1 = x1, o2 = x2;
            if (lat) { const int t = lane & 7; const float inv = exp2f(-(float)t * (13.287712379549449f / 8.0f)); const float ang = (lane < 8 ? prow : pcol) * inv;
                float s, c; sincos_rev(ang, s, c); o1 = x1 * c - x2 * s; o2 = x1 * s + x2 * c; }
            KPE[(size_t)r * 32 + lane] = f2bf(o1); KPE[(size_t)r * 32 + 16 + lane] = f2bf(o2); }
        { const int hh = lane >> 3, j0 = (lane & 7) * 4; const bf16_t* src = y + C_DK + hh * 64 + j0;
          const u32x2 a = *(const u32x2*)src, b = *(const u32x2*)(src + 32);
          float x1[4] = {bflo(a.x), bfhi(a.x), bflo(a.y), bfhi(a.y)}, x2[4] = {bflo(b.x), bfhi(b.x), bflo(b.y), bfhi(b.y)}, o1[4], o2[4];
#pragma unroll
          for (int i = 0; i < 4; ++i) { o1[i] = x1[i]; o2[i] = x2[i];
              if (lat) { const int j = j0 + i, t = j & 15; const float inv = exp2f(-(float)t * (13.287712379549449f / 16.0f)); const float ang = (j < 16 ? prow : pcol) * inv;
                  float s, c; sincos_rev(ang, s, c); o1[i] = x1[i] * c - x2[i] * s; o2[i] = x1[i] * s + x2[i] * c; } }
          u32x2 w1, w2; w1.x = cvt_pk_bf16(o1[0], o1[1]); w1.y = cvt_pk_bf16(o1[2], o1[3]); w2.x = cvt_pk_bf16(o2[0], o2[1]); w2.y = cvt_pk_bf16(o2[2], o2[3]);
          bf16_t* dst = KD + ((size_t)(hh >> 1) * LT + (size_t)r) * 256 + (hh & 1) * 64 + j0; *(u32x2*)dst = w1; *(u32x2*)(dst + 32) = w2; }
        { const u32x4 w = *(const u32x4*)(y + C_DV + lane * 8); *(u32x4*)(KD + ((size_t)(lane >> 4) * LT + (size_t)r) * 256 + 128 + (lane & 15) * 8) = w; }
    }
}

constexpr int RT_STRIDE = 1028;
__device__ __forceinline__ void phase_postmix(const Params& P, int layer, char* shm) {
    const int tid = tidx(), wid = tid >> 6, lane = tid & 63;
    float* h2s = (float*)shm;
    float* lg = (float*)(shm + 32 * RT_STRIDE * 4);
    int* hist = (int*)(shm + 32 * RT_STRIDE * 4 + 32 * 33 * 4);
    const float* g1 = P.norm_g + ((size_t)layer * 4 + 1) * 1024; const float* g2 = P.norm_g + ((size_t)layer * 4 + 2) * 1024;
    const float* rw = P.router_w + (size_t)layer * 1024 * NE; const float* rb = P.router_b + (size_t)layer * NE;
    const bf16_t* YM = WSP(const bf16_t, WS_YMIX); float* X = WSP(float, WS_X); bf16_t* H = WSP(bf16_t, WS_H);
    int* TOPE = WSP(int, WS_TOPE); float* TOPW = WSP(float, WS_TOPW); int* POS = WSP(int, WS_POS); int* cnt = WSP(int, WS_CNT) + layer * 64;
    const int nrows = (layer == DEPTH - 1) ? L : LT;
    for (int it = blockIdx.x; it < nrows / 32; it += gridDim.x) {
        const int r0 = it * 32;
        for (int hp = 0; hp < 2; ++hp) {
            f32x4 v[2][4], xv[2][4]; float ss[2], s2[2], rs[2], rs2[2];
#pragma unroll
            for (int q = 0; q < 2; ++q) { const int r = r0 + wid * 4 + hp * 2 + q;
                const float* xr = xrow_in(P, layer, r); const bf16_t* yr = YM + (size_t)r * 1024;
#pragma unroll
                for (int i = 0; i < 4; ++i) { const u32x2 yw = *(const u32x2*)(yr + i * 256 + lane * 4); v[q][i] = (f32x4){bflo(yw.x), bfhi(yw.x), bflo(yw.y), bfhi(yw.y)};
                    xv[q][i] = *(const f32x4*)(xr + i * 256 + lane * 4); } }
#pragma unroll
            for (int q = 0; q < 2; ++q) { float s = 0.f;
#pragma unroll
                for (int i = 0; i < 4; ++i) s += v[q][i][0] * v[q][i][0] + v[q][i][1] * v[q][i][1] + v[q][i][2] * v[q][i][2] + v[q][i][3] * v[q][i][3];
                ss[q] = s; }
#pragma unroll
            for (int q = 0; q < 2; ++q) ss[q] = wave_sum(ss[q]);
#pragma unroll
            for (int q = 0; q < 2; ++q) { rs[q] = rsqrtf(ss[q] * (1.0f / 1024.0f) + EPS); const int r = r0 + wid * 4 + hp * 2 + q; const float* mdq = mod_ptr(P, layer, r < L ? 0 : 1); float s = 0.f;
#pragma unroll
                for (int i = 0; i < 4; ++i) { const int c = i * 256 + lane * 4; const f32x4 g = *(const f32x4*)(g1 + c), ga = *(const f32x4*)(mdq + 2048 + c);
#pragma unroll
                    for (int j = 0; j < 4; ++j) { xv[q][i][j] += ga[j] * (v[q][i][j] * rs[q] * g[j]); s += xv[q][i][j] * xv[q][i][j]; }
                    *(f32x4*)(X + (size_t)r * 1024 + c) = xv[q][i]; }
                s2[q] = s; }
#pragma unroll
            for (int q = 0; q < 2; ++q) s2[q] = wave_sum(s2[q]);
#pragma unroll
            for (int q = 0; q < 2; ++q) { rs2[q] = rsqrtf(s2[q] * (1.0f / 1024.0f) + EPS); const int rl = wid * 4 + hp * 2 + q, r = r0 + rl; const float* mdq = mod_ptr(P, layer, r < L ? 0 : 1);
#pragma unroll
                for (int i = 0; i < 4; ++i) { const int c = i * 256 + lane * 4; const f32x4 g = *(const f32x4*)(g2 + c), sh = *(const f32x4*)(mdq + 3072 + c), sc = *(const f32x4*)(mdq + 4096 + c);
                    f32x4 o;
#pragma unroll
                    for (int j = 0; j < 4; ++j) o[j] = xv[q][i][j] * rs2[q] * g[j] * (1.0f + sc[j]) + sh[j];
                    *(f32x4*)(h2s + rl * RT_STRIDE + c) = o;
                    u32x2 w; w.x = cvt_pk_bf16(o[0], o[1]); w.y = cvt_pk_bf16(o[2], o[3]); *(u32x2*)(H + (size_t)r * 1024 + c) = w; } }
        }
        if (tid < 32) hist[tid] = 0;
        __syncthreads();
        f32x16 acc = {};
        { const int i = lane & 31, kh = lane >> 5, kb = wid * 128 + kh * 64;
          const float* ap = h2s + i * RT_STRIDE + kb; const float* bp = rw + (size_t)kb * NE + i;
#pragma unroll
          for (int s0 = 0; s0 < 64; s0 += 32) { float bv[32];
#pragma unroll
              for (int s = 0; s < 32; ++s) bv[s] = bp[(size_t)(s0 + s) * NE];
#pragma unroll
              for (int s = 0; s < 32; ++s) acc = __builtin_amdgcn_mfma_f32_32x32x2f32(ap[s0 + s], bv[s], acc, 0, 0, 0); } }
        __syncthreads();
        { float* part = h2s + wid * 1024;
#pragma unroll
          for (int rg = 0; rg < 16; ++rg) { const int row = (rg & 3) + 8 * (rg >> 2) + 4 * (lane >> 5); part[row * 32 + (lane & 31)] = acc[rg]; } }
        __syncthreads();
        for (int o = tid; o < 1024; o += NTHR) { float s = 0.f;
#pragma unroll
            for (int w = 0; w < 8; ++w) s += h2s[w * 1024 + o];
            lg[(o >> 5) * 33 + (o & 31)] = s + rb[o & 31]; }
        __syncthreads();
        int myE[4]; float myW[4]; int myRank[4];
        if (tid < 32) {
            float vals[4]; unsigned used = 0u;
#pragma unroll
            for (int k = 0; k < 4; ++k) { float best = -3.0e38f; int bi = 0;
                for (int e = 0; e < NE; ++e) { const float v = lg[tid * 33 + e]; if (!((used >> e) & 1u) && v > best) { best = v; bi = e; } }
                used |= 1u << bi; vals[k] = best; myE[k] = bi; }
            float se = 0.f;
#pragma unroll
            for (int k = 0; k < 4; ++k) { myW[k] = __expf(vals[k] - vals[0]); se += myW[k]; }
#pragma unroll
            for (int k = 0; k < 4; ++k) { myW[k] /= se; myRank[k] = atomicAdd(&hist[myE[k]], 1); }
        }
        __syncthreads();
        if (tid < 32) { const int n = hist[tid]; hist[32 + tid] = n ? atomicAdd(&cnt[tid], n) : 0; }
        __syncthreads();
        if (tid < 32) { const int r = r0 + tid;
#pragma unroll
            for (int k = 0; k < 4; ++k) { TOPE[(size_t)r * 4 + k] = myE[k]; TOPW[(size_t)r * 4 + k] = myW[k]; POS[(size_t)r * 4 + k] = hist[32 + myE[k]] + myRank[k]; } }
        __syncthreads();
    }
}

__device__ __forceinline__ void phase_gather(const Params& P, int layer, char* shm) {
    const int tid = tidx(), wid = tid >> 6, lane = tid & 63;
    int* offs = (int*)shm;
    const int* cnt = WSP(const int, WS_CNT) + layer * 64; int* TI = WSP(int, WS_TILE) + layer * 512;
    if (tid == 0) { int o = 0; for (int e = 0; e < NE; ++e) { offs[e] = o; o += (cnt[e] + 255) & ~255; } offs[32] = o; }
    __syncthreads();
    if (blockIdx.x == 0) {
        if (tid == 0) TI[0] = offs[32] >> 8;
        for (int t = tid; t < CAP_TILES; t += NTHR) { int e = 0; for (int q = 1; q < NE; ++q) if (t * 256 >= offs[q]) e = q; TI[64 + t] = e; }
    }
    int* SLOT_T = WSP(int, WS_XS);
    const int* TOPE = WSP(const int, WS_TOPE); int* POS = WSP(int, WS_POS);
    const int nrows = (layer == DEPTH - 1) ? L : LT;
    for (int i = blockIdx.x * NTHR + tid; i < nrows * 4; i += gridDim.x * NTHR) { const int slot = offs[TOPE[i]] + POS[i]; POS[i] = slot; SLOT_T[slot] = i >> 2; }
    if (blockIdx.x < NE) { const int e = blockIdx.x; for (int sl = offs[e] + cnt[e] + tid; sl < offs[e + 1]; sl += NTHR) SLOT_T[sl] = LT; }
}

__device__ __forceinline__ void phase_combine(const Params& P, int layer) {
    const int lane = tidx() & 63, gw = blockIdx.x * 8 + (tidx() >> 6), nw = gridDim.x * 8;
    const float* g3 = P.norm_g + ((size_t)layer * 4 + 3) * 1024;
    const bf16_t* YS = WSP(const bf16_t, WS_YS); float* X = WSP(float, WS_X); const int* POS = WSP(const int, WS_POS); const float* TOPW = WSP(const float, WS_TOPW);
    const bool lastl = (layer == DEPTH - 1); const int nrows = lastl ? L : LT;
    u32x4 ca[4], cb[4], na[4], nb[4]; float cw[4], nwt[4]; f32x4 cx[4], nx[4];
#define LOADROW(r_, A_, B_, W_, XV_) do { const f32x4 w4_ = *(const f32x4*)(TOPW + (size_t)(r_) * 4); const u32x4 s4_ = *(const u32x4*)(POS + (size_t)(r_) * 4); \
        W_[0] = w4_[0]; W_[1] = w4_[1]; W_[2] = w4_[2]; W_[3] = w4_[3]; const unsigned sl_[4] = {s4_.x, s4_.y, s4_.z, s4_.w}; \
        _Pragma("unroll") for (int k = 0; k < 4; ++k) { A_[k] = *(const u32x4*)(YS + (size_t)sl_[k] * 1024 + lane * 8); B_[k] = *(const u32x4*)(YS + (size_t)sl_[k] * 1024 + 512 + lane * 8); } \
        _Pragma("unroll") for (int q = 0; q < 4; ++q) XV_[q] = *(const f32x4*)(X + (size_t)(r_) * 1024 + (q >> 1) * 512 + lane * 8 + (q & 1) * 4); } while (0)
    int r = gw;
    if (r < nrows) LOADROW(r, ca, cb, cw, cx);
    for (; r < nrows; r += nw) {
        const int r2 = r + nw; const bool hn = r2 < nrows;
        if (hn) LOADROW(r2, na, nb, nwt, nx);
        const float* md = mod_ptr(P, layer, r < L ? 0 : 1);
        float f[16];
#pragma unroll
        for (int j = 0; j < 16; ++j) f[j] = 0.f;
#pragma unroll
        for (int k = 0; k < 4; ++k) { const float w = cw[k]; const u32x4 a = ca[k], b = cb[k];
            f[0] += w * bflo(a.x); f[1] += w * bfhi(a.x); f[2] += w * bflo(a.y); f[3] += w * bfhi(a.y); f[4] += w * bflo(a.z); f[5] += w * bfhi(a.z); f[6] += w * bflo(a.w); f[7] += w * bfhi(a.w);
            f[8] += w * bflo(b.x); f[9] += w * bfhi(b.x); f[10] += w * bflo(b.y); f[11] += w * bfhi(b.y); f[12] += w * bflo(b.z); f[13] += w * bfhi(b.z); f[14] += w * bflo(b.w); f[15] += w * bfhi(b.w); }
        float ss = 0.f;
#pragma unroll
        for (int j = 0; j < 16; ++j) ss += f[j] * f[j];
        ss = wave_sum(ss); const float rs = rsqrtf(ss * (1.0f / 1024.0f) + EPS);
        float* xo = lastl ? P.out + (size_t)r * 1024 : X + (size_t)r * 1024;
        float s2 = 0.f;
#pragma unroll
        for (int hlf = 0; hlf < 2; ++hlf) { const int c = hlf * 512 + lane * 8;
#pragma unroll
            for (int q = 0; q < 2; ++q) { const f32x4 xv = cx[hlf * 2 + q], g = *(const f32x4*)(g3 + c + q * 4), ga = *(const f32x4*)(md + 5120 + c + q * 4);
                f32x4 o;
#pragma unroll
                for (int j = 0; j < 4; ++j) { o[j] = xv[j] + ga[j] * (f[hlf * 8 + q * 4 + j] * rs * g[j]); f[hlf * 8 + q * 4 + j] = o[j]; s2 += o[j] * o[j]; }
                *(f32x4*)(xo + c + q * 4) = o; } }
        if (!lastl) {
            s2 = wave_sum(s2); const float rs2 = rsqrtf(s2 * (1.0f / 1024.0f) + EPS);
            const float* g0n = P.norm_g + ((size_t)(layer + 1) * 4 + 0) * 1024; const float* mdn = mod_ptr(P, layer + 1, r < L ? 0 : 1); bf16_t* H = WSP(bf16_t, WS_H);
#pragma unroll
            for (int hlf = 0; hlf < 2; ++hlf) { const int c = hlf * 512 + lane * 8; float hv[8];
#pragma unroll
                for (int q = 0; q < 2; ++q) { const f32x4 g = *(const f32x4*)(g0n + c + q * 4), sh = *(const f32x4*)(mdn + c + q * 4), sc = *(const f32x4*)(mdn + 1024 + c + q * 4);
#pragma unroll
                    for (int j = 0; j < 4; ++j) hv[q * 4 + j] = f[hlf * 8 + q * 4 + j] * rs2 * g[j] * (1.0f + sc[j]) + sh[j]; }
                u32x4 w; w.x = cvt_pk_bf16(hv[0], hv[1]); w.y = cvt_pk_bf16(hv[2], hv[3]); w.z = cvt_pk_bf16(hv[4], hv[5]); w.w = cvt_pk_bf16(hv[6], hv[7]);
                *(u32x4*)(H + (size_t)r * 1024 + c) = w; } }
        if (hn) {
#pragma unroll
            for (int k = 0; k < 4; ++k) { ca[k] = na[k]; cb[k] = nb[k]; cw[k] = nwt[k]; cx[k] = nx[k]; } }
    }
#undef LOADROW
}
#define KSWZ(row, colB) ((row) * 256 + ((colB) ^ (((row) & 7) << 4)))
#define SBAR() __builtin_amdgcn_sched_barrier(0)
__device__ __forceinline__ int crow(int r, int hi) { return (r & 3) + 8 * (r >> 2) + 4 * hi; }
template <int NVB> __device__ __forceinline__ int v_st(int k, int c) { const int kk = (k & ~0xC) | ((k & 4) << 1) | ((k & 8) >> 1); return ((kk >> 3) * NVB + (c >> 5)) * 512 + ((kk & 7) * 32 + (c & 31)) * 2; }
__device__ __forceinline__ int v_rd_base(int lane) { return ((lane & 3) << 3) | (((lane >> 2) & 3) << 6) | (((lane >> 4) & 1) << 5) | (((lane >> 5) & 1) << 8); }
template <int NVB> constexpr int v_rd_off(int d0, int ks, int half) { return ((2 * ks + half) * NVB + d0) * 512; }
template <int OFF> __device__ __forceinline__ s16x4 tr_read(int vb) { s16x4 r; asm volatile("ds_read_b64_tr_b16 %0, %1 offset:%2" : "=&v"(r) : "v"(vb), "i"(OFF) : "memory"); return r; }
#define PKF(Lo, Hi) (bf16x8){Lo[0], Lo[1], Lo[2], Lo[3], Hi[0], Hi[1], Hi[2], Hi[3]}
__device__ __forceinline__ int lds_addr(const void* p) { return (int)(uintptr_t)p; }

__device__ __forceinline__ void partialSM(f32x16& p0, f32x16& p1, float& m_reg, float& mn, float& alpha, const float C, const float THRS) {
    float pmax = p0[0];
#pragma unroll
    for (int r = 1; r < 16; ++r) pmax = fmaxf(pmax, p0[r]);
#pragma unroll
    for (int r = 0; r < 16; ++r) pmax = fmaxf(pmax, p1[r]);
    { auto rr = __builtin_amdgcn_permlane32_swap(__float_as_uint(pmax), __float_as_uint(pmax), false, false); pmax = fmaxf(__uint_as_float(rr[0]), __uint_as_float(rr[1])); }
    if (__builtin_expect(__all(pmax - m_reg <= THRS), 1)) { mn = m_reg; alpha = 1.f; }
    else { mn = fmaxf(m_reg, pmax); alpha = __builtin_amdgcn_exp2f((m_reg - mn) * C); m_reg = mn; }
    const float mnC = -mn * C;
#pragma unroll
    for (int r = 0; r < 16; ++r) p0[r] = fmaf(p0[r], C, mnC);
#pragma unroll
    for (int r = 0; r < 16; ++r) p1[r] = fmaf(p1[r], C, mnC);
#pragma unroll
    for (int r = 0; r < 16; ++r) p0[r] = __builtin_amdgcn_exp2f(p0[r]);
}
#define PK4(Pv, BASE, OUT) do { unsigned a0 = cvt_pk_bf16(Pv[BASE + 0], Pv[BASE + 1]), a1 = cvt_pk_bf16(Pv[BASE + 2], Pv[BASE + 3]);   \
    unsigned b0 = cvt_pk_bf16(Pv[BASE + 4], Pv[BASE + 5]), b1 = cvt_pk_bf16(Pv[BASE + 6], Pv[BASE + 7]);                              \
    auto r0_ = __builtin_amdgcn_permlane32_swap(a0, b0, false, false); auto r1_ = __builtin_amdgcn_permlane32_swap(a1, b1, false, false); \
    u32x4 w_ = {r0_[0], r1_[0], r0_[1], r1_[1]}; OUT = *reinterpret_cast<bf16x8*>(&w_); } while (0)
__device__ __forceinline__ void finishSM(f32x16& p0, f32x16& p1, float alpha, float& l_reg, bf16x8& pa0, bf16x8& pa1, bf16x8& pa2, bf16x8& pa3) {
#pragma unroll
    for (int r = 0; r < 16; ++r) p1[r] = __builtin_amdgcn_exp2f(p1[r]);
    float ps = 0;
#pragma unroll
    for (int r = 0; r < 16; ++r) ps += p0[r];
#pragma unroll
    for (int r = 0; r < 16; ++r) ps += p1[r];
    { auto rr = __builtin_amdgcn_permlane32_swap(__float_as_uint(ps), __float_as_uint(ps), false, false); ps = __uint_as_float(rr[0]) + __uint_as_float(rr[1]); }
    l_reg = l_reg * alpha + ps;
    PK4(p0, 0, pa0); PK4(p0, 8, pa1); PK4(p1, 0, pa2); PK4(p1, 8, pa3);
}
template <int NKD> __device__ __forceinline__ void qkt(f32x16& p0, f32x16& p1, const char* Ks, const bf16x8* qr, int r32, int hi, int cb0) {
    p0 = f32x16{}; p1 = f32x16{};
#pragma unroll
    for (int d0 = 0; d0 < NKD; ++d0) { const int cb = cb0 + (d0 * 16 + hi * 8) * 2;
        const bf16x8 b0 = *reinterpret_cast<const bf16x8*>(Ks + KSWZ(r32, cb));
        const bf16x8 b1 = *reinterpret_cast<const bf16x8*>(Ks + KSWZ(32 + r32, cb));
        p0 = __builtin_amdgcn_mfma_f32_32x32x16_bf16(b0, qr[d0], p0, 0, 0, 0);
        p1 = __builtin_amdgcn_mfma_f32_32x32x16_bf16(b1, qr[d0], p1, 0, 0, 0); }
}
template <int NVB, int D0> __device__ __forceinline__ void pv_one(f32x16& od, int vb, bf16x8 pa0, bf16x8 pa1, bf16x8 pa2, bf16x8 pa3) {
    const s16x4 l0 = tr_read<v_rd_off<NVB>(D0, 0, 0)>(vb), h0 = tr_read<v_rd_off<NVB>(D0, 0, 1)>(vb), l1 = tr_read<v_rd_off<NVB>(D0, 1, 0)>(vb), h1 = tr_read<v_rd_off<NVB>(D0, 1, 1)>(vb);
    const s16x4 l2 = tr_read<v_rd_off<NVB>(D0, 2, 0)>(vb), h2 = tr_read<v_rd_off<NVB>(D0, 2, 1)>(vb), l3 = tr_read<v_rd_off<NVB>(D0, 3, 0)>(vb), h3 = tr_read<v_rd_off<NVB>(D0, 3, 1)>(vb);
    asm volatile("s_waitcnt lgkmcnt(0)" ::: "memory"); SBAR();
    od = __builtin_amdgcn_mfma_f32_32x32x16_bf16(pa0, PKF(l0, h0), od, 0, 0, 0);
    od = __builtin_amdgcn_mfma_f32_32x32x16_bf16(pa1, PKF(l1, h1), od, 0, 0, 0);
    od = __builtin_amdgcn_mfma_f32_32x32x16_bf16(pa2, PKF(l2, h2), od, 0, 0, 0);
    od = __builtin_amdgcn_mfma_f32_32x32x16_bf16(pa3, PKF(l3, h3), od, 0, 0, 0);
}

template <bool DIFF>
__device__ __forceinline__ void attn_unit(const Params& P, int layer, char* lds, int head, int qrow0, int key0, int nkeys) {
    constexpr int NKD = DIFF ? 4 : 6, NVB = DIFF ? 4 : 2;
    constexpr int SHM_K = 64 * 256, SHM_V = 64 * NVB * 64;
    constexpr float SCALE = DIFF ? 0.125f : 0.10206207261596577f;
    constexpr float C = SCALE * 1.4426950408889634f, THRS = 8.0f / SCALE;
    const int tid = tidx(), wid = tid >> 6, lane = tid & 63, r32 = lane & 31, hi = lane >> 5;
    char* V_lds = lds; char* K_lds = lds + 2 * SHM_V;
    float* wsf = (float*)(lds + 2 * SHM_V + 2 * SHM_K) + wid * 64; float* li_l = wsf; float* al_l = wsf + 32;
    const int map = DIFF ? (wid >> 2) : 0, wrow = DIFF ? (wid & 3) * 32 : wid * 32;
    const int qrow = qrow0 + wrow + r32;
    const bf16_t* Y = WSP(const bf16_t, WS_Y); const bf16_t* KD = WSP(const bf16_t, WS_KD); const bf16_t* KVR = WSP(const bf16_t, WS_KVRAW); const bf16_t* KPE = WSP(const bf16_t, WS_KPE);
    bf16x8 qr[NKD];
    { const bf16_t* qsrc = DIFF ? (Y + (size_t)qrow * NINP + C_DQ + (2 * head + map) * 64 + hi * 8) : (WSP(const bf16_t, WS_QRAW) + (size_t)qrow * 768 + head * 96 + hi * 8);
#pragma unroll
      for (int d0 = 0; d0 < NKD; ++d0) qr[d0] = *reinterpret_cast<const bf16x8*>(qsrc + d0 * 16);
      if (qrow < L) { const float prow = (float)(qrow >> 6), pcol = (float)(qrow & 63);
          if (DIFF) {
#pragma unroll
              for (int d0 = 0; d0 < 2; ++d0)
#pragma unroll
                  for (int i = 0; i < 8; ++i) { const int t = hi * 8 + i; const float inv = exp2f(-(float)t * (13.287712379549449f / 16.0f)); const float ang = (d0 == 0 ? prow : pcol) * inv;
                      float s, c; sincos_rev(ang, s, c); const float x1 = bf2f((bf16_t)qr[d0][i]), x2 = bf2f((bf16_t)qr[d0 + 2][i]);
                      qr[d0][i] = (short)f2bf(x1 * c - x2 * s); qr[d0 + 2][i] = (short)f2bf(x1 * s + x2 * c); }
          } else {
#pragma unroll
              for (int i = 0; i < 8; ++i) { const float inv = exp2f(-(float)i * (13.287712379549449f / 8.0f)); const float ang = (hi == 0 ? prow : pcol) * inv;
                  float s, c; sincos_rev(ang, s, c); const float x1 = bf2f((bf16_t)qr[NKD - 2][i]), x2 = bf2f((bf16_t)qr[NKD - 1][i]);
                  qr[NKD - 2][i] = (short)f2bf(x1 * c - x2 * s); qr[NKD - 1][i] = (short)f2bf(x1 * s + x2 * c); }
          } } }
    const bf16_t *ksrc0, *ksrc1, *vsrc0, *vsrc1; size_t kstr, vstr; int kdst0, kdst1, vdst0, vdst1; bool k1on, v1on;
    if (DIFF) { const int sr = tid >> 4, sc = (tid & 15) * 8;
        ksrc0 = KD + (size_t)(key0 + sr) * 512 + head * 128 + sc; ksrc1 = ksrc0 + (size_t)32 * 512; kstr = 512;
        vsrc0 = Y + (size_t)(key0 + sr) * NINP + C_DV + head * 128 + sc; vsrc1 = vsrc0 + (size_t)32 * NINP; vstr = NINP;
        kdst0 = KSWZ(sr, sc * 2); kdst1 = KSWZ(32 + sr, sc * 2); vdst0 = v_st<NVB>(sr, sc); vdst1 = v_st<NVB>(32 + sr, sc); k1on = true; v1on = true;
    } else {
        { const int g = tid, row = g / 12, gi = g % 12;
          ksrc0 = gi < 8 ? KVR + (size_t)(key0 + row) * 1024 + head * 128 + gi * 8 : KPE + (size_t)(key0 + row) * 32 + (gi - 8) * 8; kdst0 = KSWZ(row, gi * 16); }
        { const int g = 512 + (tid & 255), row = g / 12, gi = g % 12;
          ksrc1 = gi < 8 ? KVR + (size_t)(key0 + row) * 1024 + head * 128 + gi * 8 : KPE + (size_t)(key0 + row) * 32 + (gi - 8) * 8; kdst1 = KSWZ(row, gi * 16); }
        kstr = 0;
        { const int row = tid >> 3, gi = tid & 7; vsrc0 = KVR + (size_t)(key0 + row) * 1024 + head * 128 + 64 + gi * 8; vdst0 = v_st<NVB>(row, gi * 8); }
        vsrc1 = vsrc0; vdst1 = vdst0; vstr = 1024; k1on = tid < 256; v1on = false;
    }
    size_t ks0 = kstr, ks1 = kstr;
    if (!DIFF) { ks0 = ((tid % 12) < 8) ? 1024 : 32; ks1 = (((512 + (tid & 255)) % 12) < 8) ? 1024 : 32; }
    bf16x8 sk0, sk1, sv0, sv1;
#define SLOAD(k0) do { sk0 = *reinterpret_cast<const bf16x8*>(ksrc0 + (size_t)(k0) * ks0); if (k1on) sk1 = *reinterpret_cast<const bf16x8*>(ksrc1 + (size_t)(k0) * ks1); \
        sv0 = *reinterpret_cast<const bf16x8*>(vsrc0 + (size_t)(k0) * vstr); if (v1on) sv1 = *reinterpret_cast<const bf16x8*>(vsrc1 + (size_t)(k0) * vstr); } while (0)
#define SWRITE(b) do { *reinterpret_cast<bf16x8*>(K_lds + (b) * SHM_K + kdst0) = sk0; if (k1on) *reinterpret_cast<bf16x8*>(K_lds + (b) * SHM_K + kdst1) = sk1; \
        *reinterpret_cast<bf16x8*>(V_lds + (b) * SHM_V + vdst0) = sv0; if (v1on) *reinterpret_cast<bf16x8*>(V_lds + (b) * SHM_V + vdst1) = sv1; } while (0)
#define SWAIT() asm volatile("s_waitcnt vmcnt(0)" ::: "memory")
#define RESC(a) do { if (__any((a) < 1.f)) { if (hi == 0) al_l[r32] = (a); asm volatile("s_waitcnt lgkmcnt(0)" ::: "memory"); \
        _Pragma("unroll") for (int d = 0; d < NVB; ++d) _Pragma("unroll") for (int r = 0; r < 16; ++r) o[d][r] *= al_l[crow(r, hi)]; } } while (0)
#define PVALL(vb) do { pv_one<NVB, 0>(o[0], vb, pa0, pa1, pa2, pa3); pv_one<NVB, 1>(o[1], vb, pa0, pa1, pa2, pa3); \
        if constexpr (NVB == 4) { pv_one<NVB, 2>(o[2], vb, pa0, pa1, pa2, pa3); pv_one<NVB, 3>(o[3], vb, pa0, pa1, pa2, pa3); } } while (0)
    const int vb0 = lds_addr(V_lds) + v_rd_base(lane);
    const int cbq = DIFF ? map * 128 : 0;
    float m_reg = -1e30f, l_reg = 0; f32x16 o[NVB];
#pragma unroll
    for (int d = 0; d < NVB; ++d) o[d] = f32x16{};
    f32x16 pA0, pA1, pB0, pB1; float mnA, mnB, alA, alB; bf16x8 pa0, pa1, pa2, pa3; const int NT = nkeys / 64;
    SLOAD(0); SWAIT(); SWRITE(0); __syncthreads();
    qkt<NKD>(pA0, pA1, K_lds, qr, r32, hi, cbq); partialSM(pA0, pA1, m_reg, mnA, alA, C, THRS);
    SLOAD(64); SWAIT(); SWRITE(1); __syncthreads();
    for (int j = 1; j + 1 < NT; j += 2) {
        SBAR(); qkt<NKD>(pB0, pB1, K_lds + SHM_K, qr, r32, hi, cbq);
        finishSM(pA0, pA1, alA, l_reg, pa0, pa1, pa2, pa3); SBAR();
        SLOAD((j + 1) * 64); SBAR();
        PVALL(vb0); partialSM(pB0, pB1, m_reg, mnB, alB, C, THRS);
        __syncthreads(); SWAIT(); SWRITE(0);
        RESC(alB); __syncthreads();
        SBAR(); qkt<NKD>(pA0, pA1, K_lds, qr, r32, hi, cbq);
        finishSM(pB0, pB1, alB, l_reg, pa0, pa1, pa2, pa3); SBAR();
        SLOAD((j + 2) * 64); SBAR();
        PVALL(vb0 + SHM_V); partialSM(pA0, pA1, m_reg, mnA, alA, C, THRS);
        __syncthreads(); SWAIT(); SWRITE(1);
        RESC(alA); __syncthreads();
    }
    SBAR(); qkt<NKD>(pB0, pB1, K_lds + SHM_K, qr, r32, hi, cbq);
    finishSM(pA0, pA1, alA, l_reg, pa0, pa1, pa2, pa3); SBAR();
    PVALL(vb0); partialSM(pB0, pB1, m_reg, mnB, alB, C, THRS);
    __syncthreads(); RESC(alB);
    finishSM(pB0, pB1, alB, l_reg, pa0, pa1, pa2, pa3); SBAR();
    PVALL(vb0 + SHM_V);
    if (hi == 0) li_l[r32] = l_reg; asm volatile("s_waitcnt lgkmcnt(0)" ::: "memory");
    float rli[16];
#pragma unroll
    for (int r = 0; r < 16; ++r) rli[r] = __builtin_amdgcn_rcpf(li_l[crow(r, hi)]);
    if (!DIFF) {
        bf16_t* YA = WSP(bf16_t, WS_YA) + (size_t)(qrow0 + wrow) * 512 + head * 64;
#pragma unroll
        for (int r = 0; r < 16; ++r) { const int orow = crow(r, hi);
#pragma unroll
            for (int d0 = 0; d0 < NVB; ++d0) YA[(size_t)orow * 512 + d0 * 32 + r32] = f2bf(o[d0][r] * rli[r]); }
        __syncthreads();
    } else {
        const float* lf = P.diff_lam + (size_t)layer * 256;
        const float lam_init = 0.8f - 0.6f * __expf(-0.3f * (float)layer);
        const float d01 = wave_sum(lf[lane] * lf[64 + lane]), d23 = wave_sum(lf[128 + lane] * lf[192 + lane]);
        const float lam = __expf(d01) - __expf(d23) + lam_init;
        __syncthreads();
        float* EX = (float*)lds;
        float* ROWS = (float*)(lds + 65536);
        if (map == 1) {
#pragma unroll
            for (int d0 = 0; d0 < NVB; ++d0)
#pragma unroll
                for (int r = 0; r < 16; ++r) EX[(((wid & 3) * 64) + d0 * 16 + r) * 64 + lane] = o[d0][r] * rli[r];
        }
        __syncthreads();
        if (map == 0) {
            float* rw_ = ROWS + (size_t)(wid & 3) * 32 * 132;
#pragma unroll
            for (int d0 = 0; d0 < NVB; ++d0)
#pragma unroll
                for (int r = 0; r < 16; ++r) { const float v = o[d0][r] * rli[r] - lam * EX[(((wid & 3) * 64) + d0 * 16 + r) * 64 + lane]; rw_[crow(r, hi) * 132 + d0 * 32 + r32] = v; }
            asm volatile("s_waitcnt lgkmcnt(0)" ::: "memory");
            const int row = lane >> 1, hf = lane & 1; const float* rp = rw_ + row * 132 + hf * 64;
            f32x4 v[16]; float ss = 0.f;
#pragma unroll
            for (int q = 0; q < 16; ++q) { v[q] = *(const f32x4*)(rp + q * 4); ss += v[q][0] * v[q][0] + v[q][1] * v[q][1] + v[q][2] * v[q][2] + v[q][3] * v[q][3]; }
            ss += swz_xor<1>(ss);
            const float rs = rsqrtf(ss * (1.0f / 128.0f) + EPS) * (1.0f - lam_init);
            const float* ng = P.diff_norm_g + (size_t)layer * 512 + head * 128 + hf * 64;
            bf16_t* dst = WSP(bf16_t, WS_YD) + (size_t)(qrow0 + wrow + row) * 512 + head * 128 + hf * 64;
#pragma unroll
            for (int q = 0; q < 8; ++q) { const f32x4 g0 = *(const f32x4*)(ng + q * 8), g1 = *(const f32x4*)(ng + q * 8 + 4); const f32x4 a = v[2 * q], b = v[2 * q + 1];
                u32x4 w; w.x = cvt_pk_bf16(a[0] * rs * g0[0], a[1] * rs * g0[1]); w.y = cvt_pk_bf16(a[2] * rs * g0[2], a[3] * rs * g0[3]);
                w.z = cvt_pk_bf16(b[0] * rs * g1[0], b[1] * rs * g1[1]); w.w = cvt_pk_bf16(b[2] * rs * g1[2], b[3] * rs * g1[3]);
                *(u32x4*)(dst + q * 8) = w; }
        }
        __syncthreads();
    }
#undef SLOAD
#undef SWRITE
#undef SWAIT
#undef RESC
#undef PVALL
}
template <int NVB> __device__ __forceinline__ int v_stn(int k, int c) { return ((k >> 3) * NVB + (c >> 5)) * 512 + ((k & 7) * 32 + (c & 31)) * 2; }
template <int NKD> __device__ __forceinline__ void kload(bf16x8 (&kf0)[NKD], bf16x8 (&kf1)[NKD], const char* Ks, int r32, int hi, int cb0) {
#pragma unroll
    for (int d0 = 0; d0 < NKD; ++d0) { const int cb = cb0 + (d0 * 16 + hi * 8) * 2;
        kf0[d0] = *reinterpret_cast<const bf16x8*>(Ks + KSWZ(r32, cb));
        kf1[d0] = *reinterpret_cast<const bf16x8*>(Ks + KSWZ(32 + r32, cb)); }
}
template <int NKD, bool BIAS> __device__ __forceinline__ void qkmma(f32x16& p0, f32x16& p1, const bf16x8 (&kf0)[NKD], const bf16x8 (&kf1)[NKD], const bf16x8* qr, const f32x16& cref, bf16x8 qx, bf16x8 ax) {
    if constexpr (BIAS) {
        p0 = __builtin_amdgcn_mfma_f32_32x32x16_bf16(ax, qx, f32x16{}, 0, 0, 0);
        p1 = __builtin_amdgcn_mfma_f32_32x32x16_bf16(ax, qx, f32x16{}, 0, 0, 0);
    } else {
        p0 = __builtin_amdgcn_mfma_f32_32x32x16_bf16(kf0[0], qr[0], cref, 0, 0, 0);
        p1 = __builtin_amdgcn_mfma_f32_32x32x16_bf16(kf1[0], qr[0], cref, 0, 0, 0);
    }
#pragma unroll
    for (int d0 = BIAS ? 0 : 1; d0 < NKD; ++d0) {
        p0 = __builtin_amdgcn_mfma_f32_32x32x16_bf16(kf0[d0], qr[d0], p0, 0, 0, 0);
        p1 = __builtin_amdgcn_mfma_f32_32x32x16_bf16(kf1[d0], qr[d0], p1, 0, 0, 0); }
}
template <int NKD, bool BIAS> __device__ __forceinline__ void qkt2(f32x16& p0, f32x16& p1, const char* Ks, const bf16x8* qr, const f32x16& cref, bf16x8 qx, bf16x8 ax, int r32, int hi, int cb0) {
    bf16x8 kf0[NKD], kf1[NKD]; kload<NKD>(kf0, kf1, Ks, r32, hi, cb0); qkmma<NKD, BIAS>(p0, p1, kf0, kf1, qr, cref, qx, ax);
}
template <int NVB, int D0> __device__ __forceinline__ void pv2_one(f32x16& od, int vb, bf16x8 b0, bf16x8 b1, bf16x8 b2, bf16x8 b3) {
    const s16x4 l0 = tr_read<v_rd_off<NVB>(D0, 0, 0)>(vb), h0 = tr_read<v_rd_off<NVB>(D0, 0, 1)>(vb), l1 = tr_read<v_rd_off<NVB>(D0, 1, 0)>(vb), h1 = tr_read<v_rd_off<NVB>(D0, 1, 1)>(vb);
    const s16x4 l2 = tr_read<v_rd_off<NVB>(D0, 2, 0)>(vb), h2 = tr_read<v_rd_off<NVB>(D0, 2, 1)>(vb), l3 = tr_read<v_rd_off<NVB>(D0, 3, 0)>(vb), h3 = tr_read<v_rd_off<NVB>(D0, 3, 1)>(vb);
    asm volatile("s_waitcnt lgkmcnt(0)" ::: "memory"); SBAR();
    od = __builtin_amdgcn_mfma_f32_32x32x16_bf16(PKF(l0, h0), b0, od, 0, 0, 0);
    od = __builtin_amdgcn_mfma_f32_32x32x16_bf16(PKF(l1, h1), b1, od, 0, 0, 0);
    od = __builtin_amdgcn_mfma_f32_32x32x16_bf16(PKF(l2, h2), b2, od, 0, 0, 0);
    od = __builtin_amdgcn_mfma_f32_32x32x16_bf16(PKF(l3, h3), b3, od, 0, 0, 0);
}
template <int NVB, int D0> __device__ __forceinline__ void pv2_pair(f32x16& oa, f32x16& ob, int vb, bf16x8 b0, bf16x8 b1, bf16x8 b2, bf16x8 b3) {
    const s16x4 l0 = tr_read<v_rd_off<NVB>(D0, 0, 0)>(vb), h0 = tr_read<v_rd_off<NVB>(D0, 0, 1)>(vb), l1 = tr_read<v_rd_off<NVB>(D0, 1, 0)>(vb), h1 = tr_read<v_rd_off<NVB>(D0, 1, 1)>(vb);
    const s16x4 l2 = tr_read<v_rd_off<NVB>(D0, 2, 0)>(vb), h2 = tr_read<v_rd_off<NVB>(D0, 2, 1)>(vb), l3 = tr_read<v_rd_off<NVB>(D0, 3, 0)>(vb), h3 = tr_read<v_rd_off<NVB>(D0, 3, 1)>(vb);
    const s16x4 m0 = tr_read<v_rd_off<NVB>(D0 + 1, 0, 0)>(vb), n0 = tr_read<v_rd_off<NVB>(D0 + 1, 0, 1)>(vb), m1 = tr_read<v_rd_off<NVB>(D0 + 1, 1, 0)>(vb), n1 = tr_read<v_rd_off<NVB>(D0 + 1, 1, 1)>(vb);
    const s16x4 m2 = tr_read<v_rd_off<NVB>(D0 + 1, 2, 0)>(vb), n2 = tr_read<v_rd_off<NVB>(D0 + 1, 2, 1)>(vb), m3 = tr_read<v_rd_off<NVB>(D0 + 1, 3, 0)>(vb), n3 = tr_read<v_rd_off<NVB>(D0 + 1, 3, 1)>(vb);
    asm volatile("s_waitcnt lgkmcnt(0)" ::: "memory"); SBAR();
    oa = __builtin_amdgcn_mfma_f32_32x32x16_bf16(PKF(l0, h0), b0, oa, 0, 0, 0); ob = __builtin_amdgcn_mfma_f32_32x32x16_bf16(PKF(m0, n0), b0, ob, 0, 0, 0);
    oa = __builtin_amdgcn_mfma_f32_32x32x16_bf16(PKF(l1, h1), b1, oa, 0, 0, 0); ob = __builtin_amdgcn_mfma_f32_32x32x16_bf16(PKF(m1, n1), b1, ob, 0, 0, 0);
    oa = __builtin_amdgcn_mfma_f32_32x32x16_bf16(PKF(l2, h2), b2, oa, 0, 0, 0); ob = __builtin_amdgcn_mfma_f32_32x32x16_bf16(PKF(m2, n2), b2, ob, 0, 0, 0);
    oa = __builtin_amdgcn_mfma_f32_32x32x16_bf16(PKF(l3, h3), b3, oa, 0, 0, 0); ob = __builtin_amdgcn_mfma_f32_32x32x16_bf16(PKF(m3, n3), b3, ob, 0, 0, 0);
}
__device__ __forceinline__ float swap_max(float v) { auto rr = __builtin_amdgcn_permlane32_swap(__float_as_uint(v), __float_as_uint(v), false, false); return fmaxf(__uint_as_float(rr[0]), __uint_as_float(rr[1])); }
__device__ __forceinline__ float swap_add(float v) { auto rr = __builtin_amdgcn_permlane32_swap(__float_as_uint(v), __float_as_uint(v), false, false); return __uint_as_float(rr[0]) + __uint_as_float(rr[1]); }
__device__ __forceinline__ bf16x8 pack8(const f32x16& p, int base) {
    u32x4 w; w.x = cvt_pk_bf16(p[base + 0], p[base + 1]); w.y = cvt_pk_bf16(p[base + 2], p[base + 3]); w.z = cvt_pk_bf16(p[base + 4], p[base + 5]); w.w = cvt_pk_bf16(p[base + 6], p[base + 7]);
    return *reinterpret_cast<bf16x8*>(&w);
}

template <int NVB> __device__ __forceinline__ void pv2_split(f32x16& oa, f32x16& ob, int vb, bf16x8 b0, bf16x8 b1, f32x16& p1, float& lb) {
    s16x4 l0 = tr_read<v_rd_off<NVB>(0, 0, 0)>(vb), h0 = tr_read<v_rd_off<NVB>(0, 0, 1)>(vb), m0 = tr_read<v_rd_off<NVB>(1, 0, 0)>(vb), n0 = tr_read<v_rd_off<NVB>(1, 0, 1)>(vb);
    s16x4 l1 = tr_read<v_rd_off<NVB>(0, 1, 0)>(vb), h1 = tr_read<v_rd_off<NVB>(0, 1, 1)>(vb), m1 = tr_read<v_rd_off<NVB>(1, 1, 0)>(vb), n1 = tr_read<v_rd_off<NVB>(1, 1, 1)>(vb);
    s16x4 l2 = tr_read<v_rd_off<NVB>(0, 2, 0)>(vb), h2 = tr_read<v_rd_off<NVB>(0, 2, 1)>(vb), m2 = tr_read<v_rd_off<NVB>(1, 2, 0)>(vb), n2 = tr_read<v_rd_off<NVB>(1, 2, 1)>(vb);
    s16x4 l3 = tr_read<v_rd_off<NVB>(0, 3, 0)>(vb), h3 = tr_read<v_rd_off<NVB>(0, 3, 1)>(vb), m3 = tr_read<v_rd_off<NVB>(1, 3, 0)>(vb), n3 = tr_read<v_rd_off<NVB>(1, 3, 1)>(vb);
    asm volatile("s_waitcnt lgkmcnt(8)" : "+v"(l0), "+v"(h0), "+v"(m0), "+v"(n0), "+v"(l1), "+v"(h1), "+v"(m1), "+v"(n1) :: "memory"); SBAR();
    oa = __builtin_amdgcn_mfma_f32_32x32x16_bf16(PKF(l0, h0), b0, oa, 0, 0, 0); ob = __builtin_amdgcn_mfma_f32_32x32x16_bf16(PKF(m0, n0), b0, ob, 0, 0, 0);
    oa = __builtin_amdgcn_mfma_f32_32x32x16_bf16(PKF(l1, h1), b1, oa, 0, 0, 0); ob = __builtin_amdgcn_mfma_f32_32x32x16_bf16(PKF(m1, n1), b1, ob, 0, 0, 0);
#pragma unroll
    for (int r = 0; r < 16; ++r) p1[r] = __builtin_amdgcn_exp2f(p1[r]);
#pragma unroll
    for (int r = 0; r < 16; ++r) lb += p1[r];
    const bf16x8 b2 = pack8(p1, 0), b3 = pack8(p1, 8);
    asm volatile("s_waitcnt lgkmcnt(0)" : "+v"(l2), "+v"(h2), "+v"(m2), "+v"(n2), "+v"(l3), "+v"(h3), "+v"(m3), "+v"(n3) :: "memory");
    oa = __builtin_amdgcn_mfma_f32_32x32x16_bf16(PKF(l2, h2), b2, oa, 0, 0, 0); ob = __builtin_amdgcn_mfma_f32_32x32x16_bf16(PKF(m2, n2), b2, ob, 0, 0, 0);
    oa = __builtin_amdgcn_mfma_f32_32x32x16_bf16(PKF(l3, h3), b3, oa, 0, 0, 0); ob = __builtin_amdgcn_mfma_f32_32x32x16_bf16(PKF(m3, n3), b3, ob, 0, 0, 0);
}
template <int NVB, int KS> __device__ __forceinline__ void pv4_read(s16x4 (&v)[8], int vb) {
    v[0] = tr_read<v_rd_off<NVB>(0, KS, 0)>(vb); v[1] = tr_read<v_rd_off<NVB>(0, KS, 1)>(vb); v[2] = tr_read<v_rd_off<NVB>(1, KS, 0)>(vb); v[3] = tr_read<v_rd_off<NVB>(1, KS, 1)>(vb);
    v[4] = tr_read<v_rd_off<NVB>(2, KS, 0)>(vb); v[5] = tr_read<v_rd_off<NVB>(2, KS, 1)>(vb); v[6] = tr_read<v_rd_off<NVB>(3, KS, 0)>(vb); v[7] = tr_read<v_rd_off<NVB>(3, KS, 1)>(vb);
}
template <int NVB> __device__ __forceinline__ void pv4_mma(f32x16 (&o)[NVB], const s16x4 (&v)[8], bf16x8 b) {
    o[0] = __builtin_amdgcn_mfma_f32_32x32x16_bf16(PKF(v[0], v[1]), b, o[0], 0, 0, 0); o[1] = __builtin_amdgcn_mfma_f32_32x32x16_bf16(PKF(v[2], v[3]), b, o[1], 0, 0, 0);
    o[2] = __builtin_amdgcn_mfma_f32_32x32x16_bf16(PKF(v[4], v[5]), b, o[2], 0, 0, 0); o[3] = __builtin_amdgcn_mfma_f32_32x32x16_bf16(PKF(v[6], v[7]), b, o[3], 0, 0, 0);
}
#define PV4_WAIT(n, v) asm volatile("s_waitcnt lgkmcnt(" #n ")" : "+v"(v[0]), "+v"(v[1]), "+v"(v[2]), "+v"(v[3]), "+v"(v[4]), "+v"(v[5]), "+v"(v[6]), "+v"(v[7]) :: "memory")
template <int NVB> __device__ __forceinline__ void pv4_split(f32x16 (&o)[NVB], int vb, bf16x8 b0, bf16x8 b1, f32x16& p1, float& lb) {
    s16x4 va[8], vb8[8];
    pv4_read<NVB, 0>(va, vb); pv4_read<NVB, 1>(vb8, vb);
    PV4_WAIT(8, va); SBAR(); pv4_mma<NVB>(o, va, b0);
    pv4_read<NVB, 2>(va, vb);
    PV4_WAIT(8, vb8); SBAR(); pv4_mma<NVB>(o, vb8, b1);
#pragma unroll
    for (int r = 0; r < 16; ++r) p1[r] = __builtin_amdgcn_exp2f(p1[r]);
#pragma unroll
    for (int r = 0; r < 16; ++r) lb += p1[r];
    const bf16x8 b2 = pack8(p1, 0), b3 = pack8(p1, 8);
    pv4_read<NVB, 3>(vb8, vb);
    PV4_WAIT(8, va); SBAR(); pv4_mma<NVB>(o, va, b2);
    PV4_WAIT(0, vb8); SBAR(); pv4_mma<NVB>(o, vb8, b3);
}
#undef PV4_WAIT
template <bool DIFF>
__device__ __forceinline__ void attn_unit3(const Params& P, int layer, char* lds, int head, int qrow0, int key0, int nkeys) {
    constexpr int NKD = DIFF ? 4 : 6, NVB = DIFF ? 4 : 2;
    constexpr int SHM_K = 64 * 256, SHM_V = 64 * NVB * 64, SLOT = SHM_K + SHM_V;
    constexpr float SCALE = DIFF ? 0.125f : 0.10206207261596577f;
    constexpr float C = SCALE * 1.4426950408889634f, THR2 = 8.0f * 1.4426950408889634f;
    const int tid = tidx(), wid = tid >> 6, lane = tid & 63, r32 = lane & 31, hi = lane >> 5;
    const int map = DIFF ? (wid >> 2) : 0, wrow = DIFF ? (wid & 3) * 32 : wid * 32;
    const int qrow = qrow0 + wrow + r32;
    const bf16_t* Y = WSP(const bf16_t, WS_Y); const bf16_t* KD = WSP(const bf16_t, WS_KD); const bf16_t* KVR = WSP(const bf16_t, WS_KVRAW); const bf16_t* KPE = WSP(const bf16_t, WS_KPE);
    bf16x8 qr[NKD];
    { const bf16_t* qsrc = DIFF ? (Y + (size_t)qrow * NINP + C_DQ + (2 * head + map) * 64 + hi * 8) : (WSP(const bf16_t, WS_QRAW) + (size_t)qrow * 768 + head * 96 + hi * 8);
#pragma unroll
      for (int d0 = 0; d0 < NKD; ++d0) qr[d0] = *reinterpret_cast<const bf16x8*>(qsrc + d0 * 16);
      const bool lat = qrow < L; const float prow = (float)(qrow >> 6), pcol = (float)(qrow & 63);
      constexpr int R0 = DIFF ? 0 : 4, RN = DIFF ? 2 : 1, RP = DIFF ? 2 : 1;
#pragma unroll
      for (int d0 = 0; d0 < NKD; ++d0) {
          const bool isx1 = (d0 >= R0 && d0 < R0 + RN), isx2 = (d0 >= R0 + RP && d0 < R0 + RP + RN);
          if (isx2) continue;
          if (isx1) {
#pragma unroll
              for (int i = 0; i < 8; ++i) { float x1 = bf2f((bf16_t)qr[d0][i]), x2 = bf2f((bf16_t)qr[d0 + RP][i]); float o1 = x1, o2 = x2;
                  if (lat) { float ang;
                      if (DIFF) { const int t = hi * 8 + i; ang = ((d0 - R0) == 0 ? prow : pcol) * exp2f(-(float)t * (13.287712379549449f / 16.0f)); }
                      else { ang = (hi == 0 ? prow : pcol) * exp2f(-(float)i * (13.287712379549449f / 8.0f)); }
                      float s, c; sincos_rev(ang, s, c); o1 = x1 * c - x2 * s; o2 = x1 * s + x2 * c; }
                  qr[d0][i] = (short)f2bf(o1 * C); qr[d0 + RP][i] = (short)f2bf(o2 * C); }
          } else {
#pragma unroll
              for (int i = 0; i < 8; ++i) qr[d0][i] = (short)f2bf(bf2f((bf16_t)qr[d0][i]) * C);
          } } }
    constexpr bool BIAS = DIFF;
    f32x16 cref = f32x16{};
    bf16x8 qx; { const u32x4 z = {0u, 0u, 0u, 0u}; qx = *reinterpret_cast<const bf16x8*>(&z); }
    bf16x8 ax; { const u32x4 w = {hi == 0 ? 0x3F803F80u : 0u, 0u, 0u, 0u}; ax = *reinterpret_cast<const bf16x8*>(&w); }
    constexpr int NCW = DIFF ? 4 : 3;
    const char* dsrc[NCW]; unsigned dstr[NCW]; int doff[NCW];
#pragma unroll
    for (int i = 0; i < NCW; ++i) { const int c = wid * NCW + i;
        if (c < 16) { const int row = 4 * c + (lane >> 4), gpos = lane & 15, g = (gpos & 8) | ((gpos ^ row) & 7);
            if (DIFF) { dsrc[i] = (const char*)(KD + ((size_t)head * LT + (size_t)(key0 + row)) * 256 + g * 8); dstr[i] = 256 * 2; }
            else if (g >= 8 && g < 12) { dsrc[i] = (const char*)(KPE + (size_t)(key0 + row) * 32 + (g - 8) * 8); dstr[i] = 32 * 2; }
            else { dsrc[i] = (const char*)(KVR + ((size_t)head * LT + (size_t)(key0 + row)) * 128 + (g & 7) * 8); dstr[i] = 128 * 2; }
            doff[i] = c * 1024;
        } else { const int cv = c - 16, stl = 2 * cv + (lane >> 5), key = 8 * (stl / NVB) + ((lane & 31) >> 2), col = 32 * (stl % NVB) + 8 * (lane & 3);
            if (DIFF) { dsrc[i] = (const char*)(KD + ((size_t)head * LT + (size_t)(key0 + key)) * 256 + 128 + col); dstr[i] = 256 * 2; }
            else { dsrc[i] = (const char*)(KVR + ((size_t)head * LT + (size_t)(key0 + key)) * 128 + 64 + col); dstr[i] = 128 * 2; }
            doff[i] = SHM_K + cv * 1024; } }
    LAS unsigned char* ldsl = (LAS unsigned char*)lds;
#pragma unroll
    for (int i = 0; i < NCW; ++i) { doff[i] = __builtin_amdgcn_readfirstlane(doff[i]); dstr[i] *= 64u; }
#define DMA(tile, so) do { _Pragma("unroll") for (int i_ = 0; i_ < NCW; ++i_) { \
        __builtin_amdgcn_global_load_lds((const unsigned*)dsrc[i_], (LAS unsigned*)(ldsl + (so) + doff[i_]), 16, 0, 0); dsrc[i_] += dstr[i_]; } } while (0)
#define WGBAR() do { asm volatile("s_waitcnt lgkmcnt(0)" ::: "memory"); __builtin_amdgcn_s_barrier(); asm volatile("" ::: "memory"); } while (0)
#define REBUILD_QX() do { const float nm_ = -mref; if constexpr (BIAS) { const unsigned hb_ = cvt_pk_bf16(nm_, 0.f) & 0xffffu; const float hf_ = __uint_as_float(hb_ << 16); \
        const unsigned lb_ = cvt_pk_bf16(nm_ - hf_, 0.f) & 0xffffu; const u32x4 w_ = {hi == 0 ? (hb_ | (lb_ << 16)) : 0u, 0u, 0u, 0u}; qx = *reinterpret_cast<const bf16x8*>(&w_); } \
        else { _Pragma("unroll") for (int r = 0; r < 16; ++r) cref[r] = nm_; asm volatile("" : "+v"(cref)); } } while (0)
#define ROWMAX(p0, p1, out) do { float t_ = p0[0]; _Pragma("unroll") for (int r = 1; r < 16; ++r) t_ = fmaxf(t_, p0[r]); _Pragma("unroll") for (int r = 0; r < 16; ++r) t_ = fmaxf(t_, p1[r]); out = swap_max(t_); } while (0)
#define EXPSUM(p0, p1) do { \
        _Pragma("unroll") for (int r = 0; r < 16; ++r) p0[r] = __builtin_amdgcn_exp2f(p0[r]); \
        _Pragma("unroll") for (int r = 0; r < 16; ++r) la += p0[r]; \
        bf0 = pack8(p0, 0); bf1 = pack8(p0, 8); } while (0)
#define ADJUST(p0, p1) do { const float ts_ = la + lb; \
        if (__builtin_expect(__any(ts_ > 1.0995116e12f), 0)) { const float tr_ = swap_max(ts_); \
            const float d_ = tr_ > 1.0995116e12f ? (float)((int)((__float_as_uint(tr_) >> 23) & 0xffu) - 127) : 0.f; const float al_ = __builtin_amdgcn_exp2f(-d_); \
            _Pragma("unroll") for (int r = 0; r < 16; ++r) { p0[r] -= d_; p1[r] -= d_; } \
            _Pragma("unroll") for (int d = 0; d < NVB; ++d) _Pragma("unroll") for (int r = 0; r < 16; ++r) o[d][r] *= al_; \
            la *= al_; lb *= al_; mref += d_; REBUILD_QX(); } } while (0)
#define PVALL(so, p1_) do { const int vb_ = vbase + (so); \
        if constexpr (NVB == 2) { pv2_split<NVB>(o[0], o[1], vb_, bf0, bf1, p1_, lb); } \
        else { pv4_split<NVB>(o, vb_, bf0, bf1, p1_, lb); } } while (0)
#define SLOTOF(k) ((((k) >= NS) ? (k) - NS : (k)) * SLOT)
#define STEPF(pc0, pc1, pn0, pn1) do { \
        const int s_cur = SLOTOF(cur), s_nxt = SLOTOF(cur + 1); \
        DMA(j + PD, SLOTOF(cur + PD)); \
        kload<NKD>(kf0, kf1, lds + s_nxt, r32, hi, cbq); SBAR(); \
        ADJUST(pc0, pc1); \
        SBAR(); qkmma<NKD, BIAS>(pn0, pn1, kf0, kf1, qr, cref, qx, ax); \
        EXPSUM(pc0, pc1); SBAR(); \
        PVALL(s_cur, pc1); \
        if constexpr (DIFF) asm volatile("s_waitcnt vmcnt(4)" ::: "memory"); else asm volatile("s_waitcnt vmcnt(3)" ::: "memory"); WGBAR(); \
        cur = (cur + 1 >= NS) ? 0 : cur + 1; ++j; } while (0)
    const int vbase = lds_addr(lds) + SHM_K + v_rd_base(lane);
    const int cbq = DIFF ? map * 128 : 0;
    float mref = 0.f, la = 0.f, lb = 0.f; f32x16 o[NVB];
#pragma unroll
    for (int d = 0; d < NVB; ++d) o[d] = f32x16{};
    f32x16 pA0, pA1, pB0, pB1; bf16x8 bf0, bf1, bf2, bf3; bf16x8 kf0[NKD], kf1[NKD]; const int NT = nkeys / 64;
    constexpr int PD = 3, NS = 4;
    int cur = 0, j = 0;
#pragma unroll
    for (int t = 0; t < PD; ++t) DMA(t, t * SLOT);
    if constexpr (DIFF) asm volatile("s_waitcnt vmcnt(4)" ::: "memory"); else asm volatile("s_waitcnt vmcnt(3)" ::: "memory");
    WGBAR();
    mref = 0.f; REBUILD_QX();
    qkt2<NKD, BIAS>(pA0, pA1, lds, qr, cref, qx, ax, r32, hi, cbq);
    { float rm0; ROWMAX(pA0, pA1, rm0); mref = rm0;
#pragma unroll
      for (int r = 0; r < 16; ++r) { pA0[r] -= rm0; pA1[r] -= rm0; }
      REBUILD_QX(); }
    while (j < NT) { STEPF(pA0, pA1, pB0, pB1); STEPF(pB0, pB1, pA0, pA1); }
    asm volatile("s_waitcnt vmcnt(0)" ::: "memory"); WGBAR();
    const float inv = __builtin_amdgcn_rcpf(swap_add(la + lb));
    if (!DIFF) {
        bf16_t* dst = WSP(bf16_t, WS_YA) + (size_t)qrow * 512 + head * 64 + 4 * hi;
#pragma unroll
        for (int d0 = 0; d0 < NVB; ++d0)
#pragma unroll
            for (int g = 0; g < 4; ++g) { u32x2 w; w.x = cvt_pk_bf16(o[d0][4 * g] * inv, o[d0][4 * g + 1] * inv); w.y = cvt_pk_bf16(o[d0][4 * g + 2] * inv, o[d0][4 * g + 3] * inv);
                *(u32x2*)(dst + d0 * 32 + g * 8) = w; }
        asm volatile("s_waitcnt vmcnt(0)" ::: "memory"); __syncthreads();
    } else {
        const float* lf = P.diff_lam + (size_t)layer * 256;
        const float lam_init = 0.8f - 0.6f * __expf(-0.3f * (float)layer);
        const float d01 = wave_sum(lf[lane] * lf[64 + lane]), d23 = wave_sum(lf[128 + lane] * lf[192 + lane]);
        const float lam = __expf(d01) - __expf(d23) + lam_init;
        float* EX = (float*)lds;
        if (map == 1) {
#pragma unroll
            for (int d0 = 0; d0 < NVB; ++d0)
#pragma unroll
                for (int r = 0; r < 16; ++r) EX[(((wid & 3) * 64) + d0 * 16 + r) * 64 + lane] = o[d0][r] * inv;
        }
        __syncthreads();
        if (map == 0) {
            float ss = 0.f;
#pragma unroll
            for (int d0 = 0; d0 < NVB; ++d0)
#pragma unroll
                for (int r = 0; r < 16; ++r) { const float v = o[d0][r] * inv - lam * EX[(((wid & 3) * 64) + d0 * 16 + r) * 64 + lane]; o[d0][r] = v; ss += v * v; }
            ss = swap_add(ss);
            const float rs = rsqrtf(ss * (1.0f / 128.0f) + EPS) * (1.0f - lam_init);
            const float* ng = P.diff_norm_g + (size_t)layer * 512 + head * 128 + 4 * hi;
            bf16_t* dst = WSP(bf16_t, WS_YD) + (size_t)qrow * 512 + head * 128 + 4 * hi;
#pragma unroll
            for (int d0 = 0; d0 < NVB; ++d0)
#pragma unroll
                for (int g = 0; g < 4; ++g) { const f32x4 gg = *(const f32x4*)(ng + d0 * 32 + g * 8);
                    u32x2 w; w.x = cvt_pk_bf16(o[d0][4 * g] * rs * gg[0], o[d0][4 * g + 1] * rs * gg[1]); w.y = cvt_pk_bf16(o[d0][4 * g + 2] * rs * gg[2], o[d0][4 * g + 3] * rs * gg[3]);
                    *(u32x2*)(dst + d0 * 32 + g * 8) = w; }
        }
        __syncthreads();
    }
#undef DMA
#undef WGBAR
#undef SLOTOF
#undef REBUILD_QX
#undef ROWMAX
#undef ADJUST
#undef EXPSUM
#undef PVALL
#undef STEPF
}
__device__ __forceinline__ float scan_sum(float v, bool fwd, int lane) {
#pragma unroll
    for (int off = 1; off < 64; off <<= 1) { const int src = fwd ? lane - off : lane + off; const float t = lane_read(v, src & 63); if (src >= 0 && src < 64) v += t; }
    return v;
}
__device__ __forceinline__ float scan_max(float v, bool fwd, int lane) {
#pragma unroll
    for (int off = 1; off < 64; off <<= 1) { const int src = fwd ? lane - off : lane + off; const float t = lane_read(v, src & 63); if (src >= 0 && src < 64) v = fmaxf(v, t); }
    return v;
}
__device__ __forceinline__ float gate_val(const bf16_t* yrow, const float* gb, int idx) {
    float g = bf2f(yrow[C_MG + idx]) + gb[idx];
    { const float e2 = __builtin_amdgcn_exp2f(g * (2.0f / 15.0f * 1.4426950408889634f)); g = 15.0f * (1.0f - 2.0f * __builtin_amdgcn_rcpf(e2 + 1.0f)); }
    if ((idx >> 2) & 1) g = fminf(g, 0.f) - __logf(1.0f + __expf(-fabsf(g)));
    return g;
}
__device__ __forceinline__ void mlstm_local_unit(const Params& P, int layer, char* lds, int pc, int h) {
    const int tid = tidx(), wid = tid >> 6, lane = tid & 63, r32 = lane & 31, hi = lane >> 5;
    char* KW = lds; char* VI = lds + 32768; float* wgt = (float*)(lds + 49152);
    const bf16_t* Y = WSP(const bf16_t, WS_Y) + (size_t)pc * 64 * NINP;
    if (wid < 2) { const int dir = wid; const bool fwd = dir == 0; const float* gb = P.m_gate_b + (size_t)layer * 16;
        const float ig = gate_val(Y + (size_t)lane * NINP, gb, dir * 8 + h), lf = gate_val(Y + (size_t)lane * NINP, gb, dir * 8 + 4 + h);
        const float bc = scan_sum(lf, fwd, lane); const float a = ig - bc; const float amax = wave_max(a);
        wgt[dir * 64 + lane] = __expf(a - amax);
        const float bl = __int_as_float(fwd ? __builtin_amdgcn_readlane(__float_as_int(bc), 63) : __builtin_amdgcn_readlane(__float_as_int(bc), 0));
        if (lane == 0) { float* sc = WSP(float, WS_SCAL) + ((size_t)(dir * 4 + h) * NCH + pc) * 2; sc[0] = bl; sc[1] = bl + amax; } }
    __syncthreads();
    { const int sr = tid >> 4, sc = (tid & 15) * 8;
#pragma unroll
      for (int q = 0; q < 2; ++q) { const int rr = sr + 32 * q; const u32x4 kv = *(const u32x4*)(Y + (size_t)rr * NINP + C_MK + h * 128 + sc), vv = *(const u32x4*)(Y + (size_t)rr * NINP + C_MV + h * 128 + sc);
          const float w0 = wgt[rr], w1 = wgt[64 + rr];
          const float kf[8] = {bflo(kv.x), bfhi(kv.x), bflo(kv.y), bfhi(kv.y), bflo(kv.z), bfhi(kv.z), bflo(kv.w), bfhi(kv.w)};
          u32x4 a, b; a.x = cvt_pk_bf16(kf[0] * w0, kf[1] * w0); a.y = cvt_pk_bf16(kf[2] * w0, kf[3] * w0); a.z = cvt_pk_bf16(kf[4] * w0, kf[5] * w0); a.w = cvt_pk_bf16(kf[6] * w0, kf[7] * w0);
          b.x = cvt_pk_bf16(kf[0] * w1, kf[1] * w1); b.y = cvt_pk_bf16(kf[2] * w1, kf[3] * w1); b.z = cvt_pk_bf16(kf[4] * w1, kf[5] * w1); b.w = cvt_pk_bf16(kf[6] * w1, kf[7] * w1);
          const int off = v_st<4>(rr, sc);
          *(u32x4*)(KW + off) = a; *(u32x4*)(KW + 16384 + off) = b; *(u32x4*)(VI + off) = vv; } }
    __syncthreads();
    const int dir = wid >> 2, rb = wid & 3, chain = dir * 4 + h;
    { const int ab = lds_addr(KW + dir * 16384) + v_rd_base(lane) + rb * 512, bb = lds_addr(VI) + v_rd_base(lane);
      f32x16 acc[4];
#pragma unroll
      for (int d = 0; d < 4; ++d) acc[d] = f32x16{};
#define M1STEP(KS) do { const s16x4 al_ = tr_read<v_rd_off<4>(0, KS, 0)>(ab), ah_ = tr_read<v_rd_off<4>(0, KS, 1)>(ab); \
        const s16x4 b0l = tr_read<v_rd_off<4>(0, KS, 0)>(bb), b0h = tr_read<v_rd_off<4>(0, KS, 1)>(bb), b1l = tr_read<v_rd_off<4>(1, KS, 0)>(bb), b1h = tr_read<v_rd_off<4>(1, KS, 1)>(bb); \
        const s16x4 b2l = tr_read<v_rd_off<4>(2, KS, 0)>(bb), b2h = tr_read<v_rd_off<4>(2, KS, 1)>(bb), b3l = tr_read<v_rd_off<4>(3, KS, 0)>(bb), b3h = tr_read<v_rd_off<4>(3, KS, 1)>(bb); \
        asm volatile("s_waitcnt lgkmcnt(0)" ::: "memory"); SBAR(); const bf16x8 af = PKF(al_, ah_); \
        acc[0] = __builtin_amdgcn_mfma_f32_32x32x16_bf16(af, PKF(b0l, b0h), acc[0], 0, 0, 0); acc[1] = __builtin_amdgcn_mfma_f32_32x32x16_bf16(af, PKF(b1l, b1h), acc[1], 0, 0, 0); \
        acc[2] = __builtin_amdgcn_mfma_f32_32x32x16_bf16(af, PKF(b2l, b2h), acc[2], 0, 0, 0); acc[3] = __builtin_amdgcn_mfma_f32_32x32x16_bf16(af, PKF(b3l, b3h), acc[3], 0, 0, 0); } while (0)
      M1STEP(0); M1STEP(1); M1STEP(2); M1STEP(3);
#undef M1STEP
      bf16_t* Cl = WSP(bf16_t, WS_CLOC) + ((size_t)chain * NCH + pc) * 16384;
#pragma unroll
      for (int d0 = 0; d0 < 4; ++d0)
#pragma unroll
          for (int r = 0; r < 16; ++r) Cl[(size_t)(rb * 32 + crow(r, hi)) * 128 + d0 * 32 + r32] = f2bf(acc[d0][r]); }
    if (tid < 256) { const int d2 = tid >> 7, d = tid & 127; float s = 0.f; const char* kw = KW + d2 * 16384;
        for (int t = 0; t < 64; ++t) s += bf2f(*(const bf16_t*)(kw + v_st<4>(t, d)));
        WSP(float, WS_NLOC)[((size_t)(d2 * 4 + h) * NCH + pc) * 128 + d] = s; }
    __syncthreads();
}
__device__ __forceinline__ void phase_mlstm_local(const Params& P, int layer, char* lds) {
    for (int u = blockIdx.x; u < NCH * 4; u += gridDim.x) mlstm_local_unit(P, layer, lds, u >> 2, u & 3);
}
__device__ __forceinline__ int chain_pc(int dir, int ci) { return dir ? (NCH - 1 - ci) : (ci < 4 ? 256 + ci : ci - 4); }
__device__ __forceinline__ void phase_mlstm_scan(const Params& P, char* shm) {
    const int tid = tidx(), lane = tid & 63, b = blockIdx.x;
    f32x2* coef = (f32x2*)shm;
    for (int gb = b; gb < 256; gb += gridDim.x) {
        const int chainC = gb >> 5;
        { const int ws_ = tid >> 6;
          if (ws_ == 0 || (ws_ < 3 && gb < 4)) { const int chain = ws_ == 0 ? chainC : 2 * gb + (ws_ - 1); const int dir = chain >> 2;
            const float* sc = WSP(const float, WS_SCAL) + (size_t)chain * NCH * 2; float* mst = WSP(float, WS_MST) + (size_t)chain * NCH;
            float a5[5], b5[5]; float A = 0.f, B = -3.0e38f;
#pragma unroll
            for (int q = 0; q < 5; ++q) { const int ci = lane * 5 + q; const bool ok = ci < NCH; const int pc = chain_pc(dir, ok ? ci : 0);
                a5[q] = ok ? sc[pc * 2] : 0.f; b5[q] = ok ? sc[pc * 2 + 1] : -3.0e38f;
                B = fmaxf(B + a5[q], b5[q]); A += a5[q]; }
#pragma unroll
            for (int off = 1; off < 64; off <<= 1) { const int src = lane - off; const float Ap = lane_read(A, src & 63), Bp = lane_read(B, src & 63);
                if (src >= 0) { B = fmaxf(Bp + A, B); A = Ap + A; } }
            float Ae = lane_read(A, (lane - 1) & 63), Be = lane_read(B, (lane - 1) & 63); if (lane == 0) { Ae = 0.f; Be = -3.0e38f; }
            float m = fmaxf(0.f + Ae, Be);
#pragma unroll
            for (int q = 0; q < 5; ++q) { const int ci = lane * 5 + q;
                if (ci < NCH) { const int pc = chain_pc(dir, ci); if (ws_ == 0 && (gb & 31) == 0) mst[pc] = m;
                    const float mn = fmaxf(a5[q] + m, b5[q]); coef[ws_ * NCH + ci] = (f32x2){__expf(a5[q] + m - mn), __expf(b5[q] - mn)}; m = mn; } } } }
        __syncthreads();
        if (tid < 256) {
            const int gtid = gb * 256 + tid, pair = gtid & 8191, dir = chainC >> 2;
            const unsigned* Cl = WSP(const unsigned, WS_CLOC) + (size_t)chainC * NCH * 8192 + pair; unsigned* Cs = WSP(unsigned, WS_CST) + (size_t)chainC * NCH * 8192 + pair;
            float c0 = 0.f, c1 = 0.f;
#pragma unroll 20
            for (int ci = 0; ci < NCH; ++ci) { const int pc = chain_pc(dir, ci); const f32x2 cf = coef[ci]; const unsigned w = Cl[(size_t)pc * 8192];
                Cs[(size_t)pc * 8192] = cvt_pk_bf16(c0, c1);
                c0 = cf[0] * c0 + cf[1] * bflo(w); c1 = cf[0] * c1 + cf[1] * bfhi(w); }
        } else if (gb < 4) {
            const int idx = gb * 256 + (tid - 256), chain = idx >> 7, d = idx & 127, dir = chain >> 2, ct = 1 + (chain - 2 * gb);
            const float* Nl = WSP(const float, WS_NLOC) + (size_t)chain * NCH * 128 + d; float* Ns = WSP(float, WS_NST) + (size_t)chain * NCH * 128 + d;
            float n = 0.f;
#pragma unroll 10
            for (int ci = 0; ci < NCH; ++ci) { const int pc = chain_pc(dir, ci); const f32x2 cf = coef[ct * NCH + ci]; const float w = Nl[(size_t)pc * 128];
                Ns[(size_t)pc * 128] = n; n = cf[0] * n + cf[1] * w; }
        }
        __syncthreads();
    }
    (void)lane;
}
__device__ __forceinline__ void mlstm_out_unit(const Params& P, int layer, char* lds, int pc, int h) {
    const int tid = tidx(), wid = tid >> 6, lane = tid & 63, r32 = lane & 31, hi = lane >> 5;
    char* KT = lds; char* VI = lds + 16384; char* CI = lds + 32768; float* HB = (float*)(lds + 98304);
    float* GA = (float*)(lds + 132096); float* NS = (float*)(lds + 134144); float* LI = (float*)(lds + 135168) + wid * 64;
    const float* GT = WSP(const float, WS_GATES) + (size_t)pc * 64 * 16; const bf16_t* Y = WSP(const bf16_t, WS_Y) + (size_t)pc * 64 * NINP;
    if (wid < 2) { const int dir = wid; const bool fwd = dir == 0; const int chain = dir * 4 + h;
        const float ig = GT[lane * 16 + dir * 8 + h], lf = GT[lane * 16 + dir * 8 + 4 + h];
        const float bc = scan_sum(lf, fwd, lane); const float a = ig - bc; const float pm = scan_max(a, fwd, lane);
        const float ms = WSP(const float, WS_MST)[(size_t)chain * NCH + pc]; const float Mj = fmaxf(ms, pm);
        GA[dir * 64 + lane] = a; GA[128 + dir * 64 + lane] = Mj; GA[256 + dir * 64 + lane] = __expf(-(bc + Mj)); GA[384 + dir * 64 + lane] = __expf(ms - Mj);
    } else if (wid < 6) { const int idx = tid - 128, dir = idx >> 7, d = idx & 127; NS[idx] = WSP(const float, WS_NST)[((size_t)(dir * 4 + h) * NCH + pc) * 128 + d]; }
    { const int sr = tid >> 4, sc = (tid & 15) * 8;
#pragma unroll
      for (int q = 0; q < 2; ++q) { const int rr = sr + 32 * q;
          *(u32x4*)(KT + KSWZ(rr, sc * 2)) = *(const u32x4*)(Y + (size_t)rr * NINP + C_MK + h * 128 + sc);
          *(u32x4*)(VI + v_st<4>(rr, sc)) = *(const u32x4*)(Y + (size_t)rr * NINP + C_MV + h * 128 + sc); }
#pragma unroll
      for (int dir = 0; dir < 2; ++dir) { const bf16_t* Cs = WSP(const bf16_t, WS_CST) + ((size_t)(dir * 4 + h) * NCH + pc) * 16384;
#pragma unroll
          for (int q = 0; q < 4; ++q) { const int dk = sr + 32 * q;
              *(u32x4*)(CI + dir * 32768 + (dk >> 6) * 16384 + v_st<4>(dk & 63, sc)) = *(const u32x4*)(Cs + (size_t)dk * 128 + sc); } } }
    __syncthreads();
    const int rh = wid & 1, dir = (wid >> 1) & 1, vh = wid >> 2;
    {
        const int j = rh * 32 + r32;
        bf16x8 qr[8];
        { const bf16_t* qsrc = Y + (size_t)j * NINP + C_MQ + h * 128 + hi * 8;
#pragma unroll
          for (int d0 = 0; d0 < 8; ++d0) qr[d0] = *reinterpret_cast<const bf16x8*>(qsrc + d0 * 16); }
        f32x16 p0, p1; qkt<8>(p0, p1, KT, qr, r32, hi, 0);
        const float Mj = GA[128 + dir * 64 + j], Wj = GA[384 + dir * 64 + j], Ej = GA[256 + dir * 64 + j];
        float den = 0.f;
#pragma unroll
        for (int r = 0; r < 16; ++r) { const int s0 = crow(r, hi), s1 = 32 + s0;
            const float a0 = GA[dir * 64 + s0], a1 = GA[dir * 64 + s1];
            const bool k0 = dir ? (s0 >= j) : (s0 <= j), k1 = dir ? (s1 >= j) : (s1 <= j);
            p0[r] = k0 ? p0[r] * __expf(a0 - Mj) : 0.f; p1[r] = k1 ? p1[r] * __expf(a1 - Mj) : 0.f; den += p0[r] + p1[r]; }
        { auto rr = __builtin_amdgcn_permlane32_swap(__float_as_uint(den), __float_as_uint(den), false, false); den = __uint_as_float(rr[0]) + __uint_as_float(rr[1]); }
        bf16x8 pa0, pa1, pa2, pa3; PK4(p0, 0, pa0); PK4(p0, 8, pa1); PK4(p1, 0, pa2); PK4(p1, 8, pa3);
        f32x16 o[2]; o[0] = f32x16{}; o[1] = f32x16{};
        const int vbv = lds_addr(VI) + v_rd_base(lane) + vh * 1024;
        pv_one<4, 0>(o[0], vbv, pa0, pa1, pa2, pa3); pv_one<4, 1>(o[1], vbv, pa0, pa1, pa2, pa3);
        float qn = 0.f; bf16x8 qs[8];
#pragma unroll
        for (int d0 = 0; d0 < 8; ++d0) { float qf[8];
#pragma unroll
            for (int i = 0; i < 8; ++i) { qf[i] = bf2f((bf16_t)qr[d0][i]); qn += qf[i] * NS[dir * 128 + d0 * 16 + hi * 8 + i]; qf[i] *= Wj; }
            u32x4 w; w.x = cvt_pk_bf16(qf[0], qf[1]); w.y = cvt_pk_bf16(qf[2], qf[3]); w.z = cvt_pk_bf16(qf[4], qf[5]); w.w = cvt_pk_bf16(qf[6], qf[7]); qs[d0] = *reinterpret_cast<bf16x8*>(&w); }
        { auto rr = __builtin_amdgcn_permlane32_swap(__float_as_uint(qn), __float_as_uint(qn), false, false); qn = __uint_as_float(rr[0]) + __uint_as_float(rr[1]); }
        den += Wj * qn;
        const int cb = lds_addr(CI + dir * 32768) + v_rd_base(lane) + vh * 1024;
        pv_one<4, 0>(o[0], cb, qs[0], qs[1], qs[2], qs[3]); pv_one<4, 1>(o[1], cb, qs[0], qs[1], qs[2], qs[3]);
        pv_one<4, 0>(o[0], cb + 16384, qs[4], qs[5], qs[6], qs[7]); pv_one<4, 1>(o[1], cb + 16384, qs[4], qs[5], qs[6], qs[7]);
        const float inv = 1.0f / fmaxf(fabsf(den), Ej);
        if (hi == 0) LI[r32] = inv; asm volatile("s_waitcnt lgkmcnt(0)" ::: "memory");
        float rinv[16];
#pragma unroll
        for (int r = 0; r < 16; ++r) rinv[r] = LI[crow(r, hi)];
        if (dir == 0) {
#pragma unroll
            for (int d = 0; d < 2; ++d)
#pragma unroll
                for (int r = 0; r < 16; ++r) HB[(rh * 32 + crow(r, hi)) * 132 + vh * 64 + d * 32 + r32] = o[d][r] * rinv[r];
        }
        __syncthreads();
        if (dir == 1) {
#pragma unroll
            for (int d = 0; d < 2; ++d)
#pragma unroll
                for (int r = 0; r < 16; ++r) HB[(rh * 32 + crow(r, hi)) * 132 + vh * 64 + d * 32 + r32] += o[d][r] * rinv[r];
        }
        __syncthreads();
    }
    { const int row = tid >> 3, seg = tid & 7; const float* hp = HB + row * 132 + seg * 16;
      f32x4 v[4]; float ss = 0.f;
#pragma unroll
      for (int q = 0; q < 4; ++q) { v[q] = *(const f32x4*)(hp + q * 4); ss += v[q][0] * v[q][0] + v[q][1] * v[q][1] + v[q][2] * v[q][2] + v[q][3] * v[q][3]; }
      ss += swz_xor<1>(ss); ss += swz_xor<2>(ss); ss += swz_xor<4>(ss);
      const float rs = rsqrtf(ss * (1.0f / 128.0f) + EPS);
      const float* ng = P.m_norm_g + (size_t)layer * 512 + h * 128 + seg * 16; const bf16_t* mo = Y + (size_t)row * NINP + C_MO + h * 128 + seg * 16;
      bf16_t* dst = WSP(bf16_t, WS_YM) + (size_t)(pc * 64 + row) * 512 + h * 128 + seg * 16;
      const u32x4 m0 = *(const u32x4*)mo, m1 = *(const u32x4*)(mo + 8);
      const float mf[16] = {bflo(m0.x), bfhi(m0.x), bflo(m0.y), bfhi(m0.y), bflo(m0.z), bfhi(m0.z), bflo(m0.w), bfhi(m0.w), bflo(m1.x), bfhi(m1.x), bflo(m1.y), bfhi(m1.y), bflo(m1.z), bfhi(m1.z), bflo(m1.w), bfhi(m1.w)};
      float ov[16];
#pragma unroll
      for (int q = 0; q < 4; ++q) { const f32x4 g = *(const f32x4*)(ng + q * 4);
#pragma unroll
          for (int i = 0; i < 4; ++i) ov[q * 4 + i] = v[q][i] * rs * g[i] * sigmoidf_(mf[q * 4 + i]); }
      u32x4 w0, w1; w0.x = cvt_pk_bf16(ov[0], ov[1]); w0.y = cvt_pk_bf16(ov[2], ov[3]); w0.z = cvt_pk_bf16(ov[4], ov[5]); w0.w = cvt_pk_bf16(ov[6], ov[7]);
      w1.x = cvt_pk_bf16(ov[8], ov[9]); w1.y = cvt_pk_bf16(ov[10], ov[11]); w1.z = cvt_pk_bf16(ov[12], ov[13]); w1.w = cvt_pk_bf16(ov[14], ov[15]);
      *(u32x4*)dst = w0; *(u32x4*)(dst + 8) = w1; }
    __syncthreads();
}

__device__ __forceinline__ void phase_mixer(const Params& P, int layer, char* lds) {
    const int G = gridDim.x, b = blockIdx.x; const bool lastl = (layer == DEPTH - 1);
    const int nA = lastl ? 512 : 520, nM3 = lastl ? 1024 : NCH * 4;
    for (int U = b; U < nA; U += G) { const int head = U & 7, qb = U >> 3; attn_unit3<false>(P, layer, lds, head, qb * 256, qb < 64 ? 0 : L, qb < 64 ? LT : LC); }
    for (int U = b; U < nA; U += G) { const int pair = U & 3, qb = U >> 2; attn_unit3<true>(P, layer, lds, pair, qb * 128, qb < 128 ? 0 : L, qb < 128 ? LT : LC); }
    for (int U = b; U < nM3; U += G) mlstm_out_unit(P, layer, lds, U >> 2, U & 3);
}

__device__ __forceinline__ void stagger_start(int nu) {
    int G = gridDim.x, c = blockIdx.x; asm volatile("" : "+s"(G), "+s"(c));
    if (units_of(nu, G, c) < units_of(nu, G, 0)) { const int k = (c >> 4) & 3; for (int t = 0; t < k; ++t) __builtin_amdgcn_s_sleep(127); }
}
__device__ __forceinline__ void phase_inproj(const Params& P, int layer, char* lds) {
    if (layer != 0) stagger_start((LT / 256) * (NINP / 256));
    pg8::DenseOrder S{LT / 256, NINP / 256, (LT / 256) * (NINP / 256), (int)gridDim.x, (int)blockIdx.x, 30, (const char*)WSP(bf16_t, WS_H), (size_t)0, (const char*)(wlayer(P, layer) + W_IN), 2048u, 2048u};
    pg8::EpiBf16 E{WSP(bf16_t, WS_Y), NINP};
    pg8::gemm_phase(( LAS unsigned char*)lds, 1024, 2048u, 2048u, S, E);
}
__device__ __forceinline__ void phase_upproj(const Params& P, int layer, char* lds) {
    { pg8::DenseOrder S{LT / 256, 3, (LT / 256) * 3, (int)gridDim.x, (int)blockIdx.x, 30, (const char*)WSP(bf16_t, WS_CQN), (size_t)0, (const char*)(wlayer(P, layer) + W_UQ), 512u, 512u};
      pg8::EpiBf16 E{WSP(bf16_t, WS_QRAW), 768};
      pg8::gemm_phase((LAS unsigned char*)lds, 256, 512u, 512u, S, E); }
    __syncthreads();
    { pg8::DenseOrder S{LT / 256, 4, (LT / 256) * 4, (int)gridDim.x, (int)blockIdx.x, 30, (const char*)WSP(bf16_t, WS_CKVN), (size_t)0, (const char*)(wlayer(P, layer) + W_UKV), 512u, 512u};
      pg8::EpiBf16HM E{WSP(bf16_t, WS_KVRAW)};
      pg8::gemm_phase((LAS unsigned char*)lds, 256, 512u, 512u, S, E); }
}
__device__ __forceinline__ void phase_merge(const Params& P, int layer, char* lds) {
    const int nM = (layer == DEPTH - 1) ? L / 256 : LT / 256;
    pg8::MergeOrder S{nM, nM * 4, (int)gridDim.x, (int)blockIdx.x, (const char*)WSP(bf16_t, WS_YM), (size_t)(WS_YA - WS_YM), (const char*)(wlayer(P, layer) + W_BR), 1024u, 1024u};
    pg8::EpiGate E{WSP(bf16_t, WS_ZCAT), 1024, WSP(const bf16_t, WS_Y) + C_GL, NINP};
    pg8::gemm_phase((LAS unsigned char*)lds, 512, 1024u, 1024u, S, E);
}
__device__ __forceinline__ void phase_wout(const Params& P, int layer, char* lds) {
    const int nM = (layer == DEPTH - 1) ? L / 256 : LT / 256;
    pg8::DenseOrder S{nM, 4, nM * 4, (int)gridDim.x, (int)blockIdx.x, 30, (const char*)WSP(bf16_t, WS_ZCAT), (size_t)0, (const char*)(wlayer(P, layer) + W_OUT3), 2048u, 6144u};
    pg8::EpiBf16 E{WSP(bf16_t, WS_YMIX), 1024};
    pg8::gemm_phase((LAS unsigned char*)lds, 1024, 2048u, 6144u, S, E);
}
constexpr int MOE_TAB_OFF = 131072, MOE_MAP_OFF = 131072 + 1280, MOE_MAXU = 10;
__device__ __forceinline__ const LAS int* moe_table(const int* TI, int nt, char* lds) {
    LAS int* ltab = (LAS int*)((LAS unsigned char*)lds + MOE_TAB_OFF);
    for (int t = tidx(); t < nt; t += NTHR) ltab[t] = TI[64 + t];
    __syncthreads();
    return ltab;
}
__device__ __forceinline__ void phase_moe_gu(const Params& P, int layer, char* lds) {
    const int* TI = WSP(const int, WS_TILE) + layer * 512; const int nt = TI[0];
    stagger_start(nt * 8);
    const LAS int* ltab = moe_table(TI, nt, lds);
    pg8::MoeOrder S{nt, 8, nt * 8, (int)gridDim.x, (int)blockIdx.x, ltab, nullptr, (const char*)(wlayer(P, layer) + W_GU), 2048u, 2048u, (size_t)2048 * 1024 * 2};
    LAS int* lmap = (LAS int*)((LAS unsigned char*)lds + MOE_MAP_OFF);
    { const int tid = tidx(); const int* XS = WSP(const int, WS_XS); unsigned rv[MOE_MAXU];
      if (tid < 256) {
#pragma unroll
          for (int i = 0; i < MOE_MAXU; ++i) { const int pm = S.pm_of(i); rv[i] = pm >= 0 ? (unsigned)XS[pm * 256 + tid] : 0u; }
#pragma unroll
          for (int i = 0; i < MOE_MAXU; ++i) lmap[i * 256 + tid] = (int)(rv[i] < (unsigned)LT ? rv[i] : (unsigned)LT); }
      __syncthreads(); }
    pg8::EpiSwiglu E{WSP(bf16_t, WS_ACT), P.b_gu + (size_t)layer * NE * 2048, ltab};
    pg8::gemm_phase_gather((LAS unsigned char*)lds, 1024, 2048u, 2048u, S, E, (const char*)WSP(bf16_t, WS_H), lmap);
}
__device__ __forceinline__ void phase_moe_down(const Params& P, int layer, char* lds) {
    const int* TI = WSP(const int, WS_TILE) + layer * 512; const int nt = TI[0];
    stagger_start(nt * 4);
    const LAS int* ltab = moe_table(TI, nt, lds);
    pg8::MoeOrder S{nt, 4, nt * 4, (int)gridDim.x, (int)blockIdx.x, ltab, (const char*)WSP(bf16_t, WS_ACT), (const char*)(wlayer(P, layer) + W_DN), 2048u, 2048u, (size_t)1024 * 1024 * 2};
    pg8::EpiDown E{WSP(bf16_t, WS_YS), P.b_down + (size_t)layer * NE * 1024, ltab};
    pg8::gemm_phase((LAS unsigned char*)lds, 1024, 2048u, 2048u, S, E);
}
__global__ void __launch_bounds__(NTHR, 2) k_mega(Params P) {
    extern __shared__ __attribute__((aligned(16))) char shm[];
    tid_setup();
    volatile LAS unsigned* st = (volatile LAS unsigned*)(shm + LDS_BYTES - 16);
    if (tidx() == 0) { st[0] = 0u; st[1] = 0u; st[2] = 0u; st[3] = 0u; }
    __syncthreads();
    (void)xcd_barrier_post(WSP(unsigned, WS_BAR), st);
#define GRID_BAR() do { XcdBarrier b_; b_.bar = WSP(unsigned, WS_BAR); b_.x = xb_xcc_id(); b_.st = st; xcd_barrier(b_); } while (0)
    phase_p0(P, shm);
    GRID_BAR();
    _Pragma("unroll 1") for (int layer = 0; layer < DEPTH; ++layer) {
        if (layer == 0) { phase_modulate1(P, layer);                 GRID_BAR(); }
        phase_inproj(P, layer, shm);
        if (layer == 0) { const int G = gridDim.x, nu = (LT / 256) * (NINP / 256); if (units_of(nu, G, blockIdx.x) < units_of(nu, G, 0)) conv_pull(P, shm, 5); }
                                                                     GRID_BAR();
        phase_prep(P, layer); phase_mlstm_local(P, layer, shm);      GRID_BAR();
        phase_mlstm_scan(P, shm); phase_upproj(P, layer, shm);       GRID_BAR();
        phase_mixer(P, layer, shm);                                  GRID_BAR();
        phase_merge(P, layer, shm);
        if (layer == 0) { const int G = gridDim.x, nu = (LT / 256) * 4; if (units_of(nu, G, blockIdx.x) < units_of(nu, G, 0)) conv_pull(P, shm, 8); }
                                                                     GRID_BAR();
        phase_wout(P, layer, shm);
        if (layer == 0) { const int G = gridDim.x, nu = (LT / 256) * 4; if (units_of(nu, G, blockIdx.x) < units_of(nu, G, 0)) conv_pull(P, shm, 5); }
                                                                     GRID_BAR();
        phase_postmix(P, layer, shm);                                GRID_BAR();
        phase_gather(P, layer, shm);                                 GRID_BAR();
        phase_moe_gu(P, layer, shm);                                 GRID_BAR();
        phase_moe_down(P, layer, shm);                               GRID_BAR();
        phase_combine(P, layer);                                     if (layer == 0) conv_pull(P, shm, -1);
                                                                     if (layer + 1 < DEPTH) GRID_BAR();
    }
}

extern "C" void kernel_launch(void* const* d_in, const int* in_sizes, int n_in, void* d_out, int out_size, void* d_ws, size_t ws_size, hipStream_t stream) {
    (void)in_sizes; (void)n_in; (void)out_size;
    if (ws_size < WS_END) return;
    static int grid = 0;
    if (grid == 0) {
        int dev = 0, cus = 0, per_cu = 0;
        (void)hipGetDevice(&dev);
        (void)hipDeviceGetAttribute(&cus, hipDeviceAttributeMultiprocessorCount, dev);
        (void)hipFuncSetAttribute((const void*)k_mega, hipFuncAttributeMaxDynamicSharedMemorySize, LDS_BYTES);
        (void)hipOccupancyMaxActiveBlocksPerMultiprocessor(&per_cu, (const void*)k_mega, NTHR, LDS_BYTES);
        (void)hipGetLastError();
        if (cus <= 0) cus = 256;
        grid = cus;
    }
    Params P{};
    const float** pp = (const float**)&P;
    for (int i = 0; i < 24; ++i) pp[i] = (const float*)d_in[i];
    P.out = (float*)d_out; P.ws = (unsigned char*)d_ws;
    (void)hipMemsetAsync((char*)d_ws + WS_BAR, 0, 16384, stream);
    hipLaunchKernelGGL(k_mega, dim3(grid), dim3(NTHR), LDS_BYTES, stream, P);
}
```

```cpp
#include <hip/hip_runtime.h>
#include <stdint.h>

#define LAS __attribute__((address_space(3)))
typedef unsigned short bf16_t;
typedef short bf16x8 __attribute__((ext_vector_type(8)));
typedef short s16x4 __attribute__((ext_vector_type(4)));
typedef float f32x2 __attribute__((ext_vector_type(2)));
typedef float f32x4 __attribute__((ext_vector_type(4)));
typedef float f32x16 __attribute__((ext_vector_type(16)));
typedef unsigned u32x2 __attribute__((ext_vector_type(2)));
typedef unsigned u32x4 __attribute__((ext_vector_type(4)));

constexpr int DM = 1024, L = 16384, LC = 256, LT = L + LC, DEPTH = 2;
constexpr int NIN = 7088, NINP = 7168;
constexpr int C_MQ = 0, C_MK = 512, C_MV = 1024, C_MO = 1536, C_MG = 2048, C_CQ = 2064, C_CKV = 2320, C_KPE = 2448, C_DQ = 2480, C_DK = 2992, C_DV = 3504, C_GL = 4016;
constexpr int NE = 32, DE = 1024;
constexpr int NCH = LT / 64;
constexpr int CAP_TILES = 292;
constexpr float EPS = 1e-6f;
constexpr int NTHR = 512;
constexpr int LDS_BYTES = 147456;

constexpr size_t al256(size_t x) { return (x + 255) & ~(size_t)255; }
constexpr size_t WS_BAR = 0;
constexpr size_t WS_CNT = 16384;
constexpr size_t WS_TILE = WS_CNT + 1024;
constexpr size_t WS_MOD = WS_TILE + 4096;
constexpr size_t WS_W = al256(WS_MOD + (size_t)DEPTH * 2 * 6144 * 4);
constexpr size_t W_IN = 0;
constexpr size_t W_UQ = W_IN + (size_t)NINP * 1024 * 2;
constexpr size_t W_UKV = W_UQ + (size_t)768 * 256 * 2;
constexpr size_t W_BR = W_UKV + (size_t)1024 * 256 * 2;
constexpr size_t W_OUT3 = W_BR + (size_t)3072 * 512 * 2;
constexpr size_t W_GU = W_OUT3 + (size_t)1024 * 3072 * 2;
constexpr size_t W_DN = W_GU + (size_t)NE * 2048 * 1024 * 2;
constexpr size_t W_LAYER = W_DN + (size_t)NE * 1024 * 1024 * 2;
constexpr size_t WS_X = al256(WS_W + DEPTH * W_LAYER);
constexpr size_t WS_H = al256(WS_X + (size_t)LT * 1024 * 4);
constexpr size_t WS_Y = al256(WS_H + (size_t)(LT + 1) * 1024 * 2);
constexpr size_t WS_GATES = al256(WS_Y + (size_t)LT * NINP * 2);
constexpr size_t WS_CQN = al256(WS_GATES + (size_t)LT * 16 * 4);
constexpr size_t WS_CKVN = al256(WS_CQN + (size_t)LT * 256 * 2);
constexpr size_t WS_KPE = al256(WS_CKVN + (size_t)LT * 256 * 2);
constexpr size_t WS_KD = al256(WS_KPE + (size_t)LT * 32 * 2);
constexpr size_t WS_QRAW = al256(WS_KD + (size_t)LT * 1024 * 2);
constexpr size_t WS_KVRAW = al256(WS_QRAW + (size_t)LT * 768 * 2);
constexpr size_t WS_CLOC = al256(WS_KVRAW + (size_t)LT * 1024 * 2);
constexpr size_t WS_CST = al256(WS_CLOC + (size_t)8 * NCH * 16384 * 2);
constexpr size_t WS_NLOC = al256(WS_CST + (size_t)8 * NCH * 16384 * 2);
constexpr size_t WS_NST = al256(WS_NLOC + (size_t)8 * NCH * 128 * 4);
constexpr size_t WS_SCAL = al256(WS_NST + (size_t)8 * NCH * 128 * 4);
constexpr size_t WS_MST = al256(WS_SCAL + (size_t)8 * NCH * 2 * 4);
constexpr size_t WS_YM = al256(WS_MST + (size_t)8 * NCH * 4);
constexpr size_t WS_YA = al256(WS_YM + (size_t)LT * 512 * 2);
constexpr size_t WS_YD = al256(WS_YA + (size_t)LT * 512 * 2);
constexpr size_t WS_ZCAT = al256(WS_YD + (size_t)LT * 512 * 2);
constexpr size_t WS_YMIX = al256(WS_ZCAT + (size_t)LT * 3072 * 2);
constexpr size_t WS_TOPE = al256(WS_YMIX + (size_t)LT * 1024 * 4);
constexpr size_t WS_TOPW = al256(WS_TOPE + (size_t)LT * 4 * 4);
constexpr size_t WS_POS = al256(WS_TOPW + (size_t)LT * 4 * 4);
constexpr size_t WS_XS = al256(WS_POS + (size_t)LT * 4 * 4);
constexpr size_t WS_ACT = al256(WS_XS + (size_t)CAP_TILES * 256 * 1024 * 2);
constexpr size_t WS_YS = al256(WS_ACT + (size_t)CAP_TILES * 256 * 1024 * 2);
constexpr size_t WS_END = al256(WS_YS + (size_t)CAP_TILES * 256 * 1024 * 2);

struct Params {
    const float* x; const float* c; const float* ctx; const float* c_ctx; const float* ada_w; const float* ada_b; const float* norm_g; const float* w_in;
    const float* m_gate_b; const float* m_norm_g; const float* q_norm_g; const float* w_uq; const float* kv_norm_g; const float* w_ukv; const float* diff_lam;
    const float* diff_norm_g; const float* w_branch; const float* w_out; const float* router_w; const float* router_b; const float* w_gu; const float* b_gu;
    const float* w_down; const float* b_down;
    float* out; unsigned char* ws;
};

constexpr int TIDTAB_OFF = LDS_BYTES - 512;
__device__ __forceinline__ int hw_wave_slot() { return (int)(__builtin_amdgcn_s_getreg((5 << 11) | 4) & 63u); }
__device__ __forceinline__ void tid_setup() { if ((threadIdx.x & 63) == 0) ((volatile LAS int*)(uintptr_t)TIDTAB_OFF)[hw_wave_slot()] = (int)(threadIdx.x >> 6); __syncthreads(); }
__device__ __forceinline__ int tidx() {
    const int wv = ((volatile LAS int*)(uintptr_t)TIDTAB_OFF)[hw_wave_slot()];
    int ln; asm volatile("v_mbcnt_lo_u32_b32 %0, -1, 0\n\tv_mbcnt_hi_u32_b32 %0, -1, %0" : "=v"(ln));
    return (__builtin_amdgcn_readfirstlane(wv) << 6) | ln; }
typedef __bf16 bf16x2_t __attribute__((ext_vector_type(2)));
__device__ __forceinline__ unsigned cvt_pk_bf16(float lo, float hi) { const f32x2 f = {lo, hi}; const bf16x2_t v = __builtin_convertvector(f, bf16x2_t); return __builtin_bit_cast(unsigned, v); }
__device__ __forceinline__ float bf2f(bf16_t b) { return __uint_as_float(((unsigned)b) << 16); }
__device__ __forceinline__ float bflo(unsigned w) { return __uint_as_float(w << 16); }
__device__ __forceinline__ float bfhi(unsigned w) { return __uint_as_float(w & 0xffff0000u); }
__device__ __forceinline__ bf16_t f2bf(float f) { return (bf16_t)(cvt_pk_bf16(f, 0.f) & 0xffffu); }
template <int XM> __device__ __forceinline__ float swz_xor(float v) { return __int_as_float(__builtin_amdgcn_ds_swizzle(__float_as_int(v), (XM << 10) | 0x1f)); }
__device__ __forceinline__ float half_swap_add(float v) { auto rr = __builtin_amdgcn_permlane32_swap(__float_as_uint(v), __float_as_uint(v), false, false); return __uint_as_float(rr[0]) + __uint_as_float(rr[1]); }
__device__ __forceinline__ float half_swap_max(float v) { auto rr = __builtin_amdgcn_permlane32_swap(__float_as_uint(v), __float_as_uint(v), false, false); return fmaxf(__uint_as_float(rr[0]), __uint_as_float(rr[1])); }
__device__ __forceinline__ float wave_sum(float v) { v += swz_xor<16>(v); v += swz_xor<8>(v); v += swz_xor<4>(v); v += swz_xor<2>(v); v += swz_xor<1>(v); return half_swap_add(v); }
__device__ __forceinline__ float wave_max(float v) { v = fmaxf(v, swz_xor<16>(v)); v = fmaxf(v, swz_xor<8>(v)); v = fmaxf(v, swz_xor<4>(v)); v = fmaxf(v, swz_xor<2>(v)); v = fmaxf(v, swz_xor<1>(v)); return half_swap_max(v); }
__device__ __forceinline__ float lane_read(float v, int src_lane) { return __int_as_float(__builtin_amdgcn_ds_bpermute(src_lane << 2, __float_as_int(v))); }
__device__ __forceinline__ float sigmoidf_(float x) { return __builtin_amdgcn_rcpf(1.0f + __builtin_amdgcn_exp2f(-1.4426950408889634f * x)); }
__device__ __forceinline__ void sincos_rev(float ang, float& s, float& c) {
    float rev = ang * 0.15915494309189535f; rev -= floorf(rev);
    s = __builtin_amdgcn_sinf(rev); c = __builtin_amdgcn_cosf(rev);
}

#define XB_TMO      128
#define XB_XCNT(j)  (256  + 64 * (j))
#define XB_XSUB(j)  (1280 + 64 * (j))
#define XB_XGEN(j)  (2304 + 64 * (j))
#define XB_TOP      3328
#define XB_TOPGEN   3392
#define XCD_BAR_WORDS 3456
#define XB_SPIN_CAP (1u << 22)

__device__ __forceinline__ unsigned xb_ld(unsigned* p)              { return __hip_atomic_load(p, __ATOMIC_RELAXED, __HIP_MEMORY_SCOPE_AGENT); }
__device__ __forceinline__ unsigned xb_add(unsigned* p, unsigned v) { return __hip_atomic_fetch_add(p, v, __ATOMIC_RELAXED, __HIP_MEMORY_SCOPE_AGENT); }
__device__ __forceinline__ unsigned xb_xcc_id() { return (unsigned)__builtin_amdgcn_s_getreg((3 << 11) | 20) & 0xFu; }
#define XB_SPIN(cond, bar) do { unsigned _sp = 0; while (cond) { __builtin_amdgcn_s_sleep(1); \
    if ((++_sp & 255u) == 0u) { if (xb_ld(&(bar)[XB_TMO])) break; if (_sp > XB_SPIN_CAP) { atomicAdd(&(bar)[XB_TMO], 1u); break; } } } } while (0)

struct XcdBarrier { unsigned* bar; unsigned x; volatile LAS unsigned* st; };

__device__ __forceinline__ XcdBarrier xcd_barrier_post(unsigned* bar, volatile LAS unsigned* st) {
    XcdBarrier b; b.bar = bar; b.x = xb_xcc_id(); b.st = st;
    if (tidx() == 0) (void)xb_add(&bar[XB_XCNT(b.x)], 1u);
    return b;
}
__device__ __forceinline__ void xcd_barrier_complete(unsigned* bar, unsigned x, unsigned& nloc, unsigned& nx) {
    const unsigned G = gridDim.x * gridDim.y * gridDim.z;
    unsigned sum, cnt, mine, sp = 0u;
    for (;;) {
        sum = 0u; cnt = 0u; mine = 0u;
#pragma unroll
        for (unsigned j = 0; j < 16; ++j) { const unsigned c = xb_ld(&bar[XB_XCNT(j)]); sum += c; cnt += (c > 0u) ? 1u : 0u; mine = (j == x) ? c : mine; }
        if (sum == G) break;
        __builtin_amdgcn_s_sleep(1);
        if ((++sp & 255u) == 0u) { if (xb_ld(&bar[XB_TMO])) break; if (sp > XB_SPIN_CAP) { atomicAdd(&bar[XB_TMO], 1u); break; } }
    }
    nloc = mine > 0u ? mine : 1u; nx = cnt > 0u ? cnt : 1u;
}
__device__ __forceinline__ void xcd_barrier(const XcdBarrier& b) {
    asm volatile("s_waitcnt vmcnt(0)" ::: "memory");
    __syncthreads();
    if (tidx() == 0) {
        unsigned* bar = b.bar;
        __builtin_amdgcn_s_waitcnt(0);
        unsigned nloc = b.st[0], nx = b.st[1];
        if (nloc == 0u) { xcd_barrier_complete(bar, b.x, nloc, nx); b.st[0] = nloc; b.st[1] = nx; }
        const unsigned old = xb_add(&bar[XB_XSUB(b.x)], 1u);
        const unsigned gen = old / nloc;
        if (old + 1u == (gen + 1u) * nloc) {
            __builtin_amdgcn_fence(__ATOMIC_RELEASE, "agent");
            asm volatile("s_waitcnt vmcnt(0)" ::: "memory");
            const unsigned og = xb_add(&bar[XB_TOP], 1u);
            const unsigned tg = og / nx;
            if (og + 1u == (tg + 1u) * nx) xb_add(&bar[XB_TOPGEN], 1u);
            else XB_SPIN(xb_ld(&bar[XB_TOPGEN]) == tg, bar);
            __builtin_amdgcn_fence(__ATOMIC_ACQUIRE, "agent");
            xb_add(&bar[XB_XGEN(b.x)], 1u);
            asm volatile("s_waitcnt vmcnt(0)" ::: "memory");
        } else {
            XB_SPIN(xb_ld(&bar[XB_XGEN(b.x)]) == gen, bar);
            __builtin_amdgcn_fence(__ATOMIC_ACQUIRE, "agent");
            asm volatile("s_waitcnt vmcnt(0)" ::: "memory");
        }
    }
    __syncthreads();
}

namespace pg8 {
constexpr int BM = 256, BK = 64, HALF = 128, HTB = HALF * BK * 2, STAGE_BYTES = 8 * HTB, NXCD = 8, WGM = 8;
__device__ __forceinline__ int lds_byte(int r, int c) { const int st = (r >> 4) * 2 + (c >> 5), rr = r & 15, cc = c & 31, ob = rr * 64 + cc * 2; return st * 1024 + (ob ^ (((ob >> 9) & 1) << 5)); }
__device__ __forceinline__ void stage_rc(int b, int& R, int& C) { const int st = b / 1024, sb = b % 1024, swz = sb ^ (((sb >> 9) & 1) << 5); R = (st >> 1) * 16 + swz / 64; C = (st & 1) * 32 + (swz % 64) / 2; }
__device__ __forceinline__ int perm32(int rho) { const int n = rho >> 4, i = rho & 15; return 8 * (i >> 2) + 4 * n + (i & 3); }

struct Unit { int pm, pn; const char* A; const char* B; };

__device__ __forceinline__ int xcd_remap(int wgid, int nwg) { const int q = nwg / NXCD, r = nwg % NXCD, xcd = wgid % NXCD, off = wgid / NXCD; return (xcd < r ? xcd * (q + 1) : r * (q + 1) + (xcd - r) * q) + off; }

template <class Epi, class Sched>
__device__ __forceinline__ void gemm_phase(LAS unsigned char* lds, const int K, const unsigned lda, const unsigned ldb, const Sched& S, const Epi& E) {
    const int tid = tidx(), wid = __builtin_amdgcn_readfirstlane(tid >> 6), lane = tid & 63, wr = wid >> 2, wc = wid & 3, fr = lane & 15, fq = lane >> 4;
    const int nt = K / BK;
    unsigned voffA[2], voffB[2];
#pragma unroll
    for (int i = 0; i < 2; ++i) { int R, C; stage_rc(tid * 16 + i * 8192, R, C); const int Rb = Epi::PERM ? ((R & ~31) + perm32(R & 31)) : R;
        voffA[i] = (unsigned)R * lda + (unsigned)C * 2u; voffB[i] = (unsigned)Rb * ldb + (unsigned)C * 2u; }
    const size_t kstep = (size_t)(BK * 2);
    const size_t hstepA = (size_t)HALF * lda, hstepB = (size_t)HALF * ldb;
    const unsigned ldsw = (unsigned)wid * 1024u;
    const int aoff = lds_byte(wr * 64 + fr, fq * 8), boff = lds_byte(wc * 32 + fr, fq * 8);
#define PG8_SA(b, h) (((b) * 2 + (h)) * HTB)
#define PG8_SB(b, h) ((4 + (b) * 2 + (h)) * HTB)
#define PG8_STAGE(bufoff, gbase, voff) do { _Pragma("unroll") for (int _i = 0; _i < 2; ++_i) \
        __builtin_amdgcn_global_load_lds((const unsigned*)((const char*)(gbase) + (voff)[_i]), (LAS unsigned*)(lds + (bufoff) + ldsw + _i * 8192), 16, 0, 0); } while (0)
#define PG8_LDA(dst, b, h) do { _Pragma("unroll") for (int m = 0; m < 4; ++m) _Pragma("unroll") for (int k = 0; k < 2; ++k) dst[m][k] = *(const LAS bf16x8*)(lds + PG8_SA(b, h) + aoff + m * 2048 + k * 1024); } while (0)
#define PG8_LDB(dst, b, h) do { _Pragma("unroll") for (int n = 0; n < 2; ++n) _Pragma("unroll") for (int k = 0; k < 2; ++k) dst[n][k] = *(const LAS bf16x8*)(lds + PG8_SB(b, h) + boff + n * 2048 + k * 1024); } while (0)
#define PG8_MMA(ai, bj, At, Bt) do { __builtin_amdgcn_s_setprio(1); _Pragma("unroll") for (int m = 0; m < 4; ++m) _Pragma("unroll") for (int n = 0; n < 2; ++n) _Pragma("unroll") for (int k = 0; k < 2; ++k) \
        acc[ai][bj][m][n] = __builtin_amdgcn_mfma_f32_16x16x32_bf16(Bt[n][k], At[m][k], acc[ai][bj][m][n], 0, 0, 0); __builtin_amdgcn_s_setprio(0); } while (0)
#define PG8_WAIT_V(n) asm volatile("s_waitcnt vmcnt(" #n ")" ::: "memory")
#define PG8_WAIT_VE(relax) asm volatile("s_waitcnt vmcnt(%1)\n\ts_cmp_lg_u32 %0, 0\n\ts_cbranch_scc1 1f\n\ts_waitcnt vmcnt(6)\n1:" :: "s"(relax), "i"(6 + Epi::NST) : "memory", "scc")
#define PG8_WAIT_L(n) asm volatile("s_waitcnt lgkmcnt(" #n ")" ::: "memory")
#define PG8_BAR __builtin_amdgcn_s_barrier()
#define PG8_SCHED __builtin_amdgcn_sched_barrier(0)
    Unit cur, nxt; int ui = 0;
    if (!S.next(0, cur)) return;
    f32x4 acc[2][2][4][2];
#pragma unroll
    for (int a = 0; a < 2; ++a)
#pragma unroll
        for (int b = 0; b < 2; ++b)
#pragma unroll
            for (int m = 0; m < 4; ++m)
#pragma unroll
                for (int n = 0; n < 2; ++n) acc[a][b][m][n] = (f32x4){0.f, 0.f, 0.f, 0.f};
    bf16x8 At[4][2], B0[2][2], B1[2][2];
    const char* cA = cur.A; const char* cB = cur.B;
    PG8_STAGE(PG8_SB(0, 0), cB, voffB); PG8_STAGE(PG8_SA(0, 0), cA, voffA); PG8_STAGE(PG8_SB(0, 1), cB + hstepB, voffB); PG8_STAGE(PG8_SA(0, 1), cA + hstepA, voffA);
    if (wr == 1) PG8_BAR;
    PG8_WAIT_V(4); PG8_BAR;
    PG8_STAGE(PG8_SB(1, 0), cB + kstep, voffB); PG8_STAGE(PG8_SA(1, 0), cA + kstep, voffA); PG8_STAGE(PG8_SB(1, 1), cB + hstepB + kstep, voffB); PG8_STAGE(PG8_SA(1, 1), cA + kstep + hstepA, voffA);
    PG8_WAIT_V(8); PG8_BAR;
    for (;;) {
        const bool has_next = S.next(ui + 1, nxt);
        const char* nA = has_next ? nxt.A : cA; const char* nB = has_next ? nxt.B : cB;
        for (int t = 0; t < nt; t += 2) {
            const bool last = (t == nt - 2);
            const char* a2 = last ? nA : cA + (size_t)(t + 2) * kstep; const char* b2 = last ? nB : cB + (size_t)(t + 2) * kstep;
            const char* a3 = a2 + kstep; const char* b3 = b2 + kstep;
            PG8_LDB(B0, 0, 0); PG8_SCHED; PG8_LDA(At, 0, 0);
            PG8_WAIT_L(8); PG8_BAR; PG8_WAIT_L(0); PG8_MMA(0, 0, At, B0); PG8_BAR; PG8_SCHED;
            PG8_LDB(B1, 0, 1); PG8_STAGE(PG8_SB(0, 0), b2, voffB);
            PG8_BAR; PG8_WAIT_L(0); PG8_MMA(0, 1, At, B1); PG8_BAR;
            PG8_LDA(At, 0, 1); PG8_STAGE(PG8_SA(0, 0), a2, voffA);
            PG8_BAR; PG8_WAIT_L(0); PG8_MMA(1, 0, At, B0); PG8_BAR; PG8_SCHED;
            PG8_STAGE(PG8_SB(0, 1), b2 + hstepB, voffB);
            PG8_WAIT_VE(__builtin_amdgcn_readfirstlane((int)(t == 0 && ui != 0)));
            PG8_BAR; PG8_MMA(1, 1, At, B1); PG8_BAR;
            PG8_LDB(B0, 1, 0); PG8_SCHED; PG8_LDA(At, 1, 0); PG8_STAGE(PG8_SA(0, 1), a2 + hstepA, voffA);
            PG8_WAIT_L(8); PG8_BAR; PG8_WAIT_L(0); PG8_MMA(0, 0, At, B0); PG8_BAR; PG8_SCHED;
            PG8_LDB(B1, 1, 1); PG8_STAGE(PG8_SB(1, 0), b3, voffB);
            PG8_BAR; PG8_WAIT_L(0); PG8_MMA(0, 1, At, B1); PG8_BAR;
            PG8_LDA(At, 1, 1); PG8_STAGE(PG8_SA(1, 0), a3, voffA);
            PG8_BAR; PG8_WAIT_L(0); PG8_MMA(1, 0, At, B0); PG8_BAR; PG8_SCHED;
            PG8_STAGE(PG8_SB(1, 1), b3 + hstepB, voffB);
            PG8_WAIT_V(6); PG8_BAR; PG8_MMA(1, 1, At, B1); PG8_BAR;
            PG8_STAGE(PG8_SA(1, 1), a3 + hstepA, voffA);
            asm volatile("" ::: "memory");
        }
        E(acc, cur, wr, wc, fr, fq);
        if (!has_next) break;
#pragma unroll
        for (int a = 0; a < 2; ++a)
#pragma unroll
            for (int b = 0; b < 2; ++b)
#pragma unroll
                for (int m = 0; m < 4; ++m)
#pragma unroll
                    for (int n = 0; n < 2; ++n) acc[a][b][m][n] = (f32x4){0.f, 0.f, 0.f, 0.f};
        cur = nxt; cA = nA; cB = nB; ++ui;
    }
    PG8_WAIT_V(0);
    if (wr == 0) PG8_BAR;
    PG8_BAR;
#undef PG8_SA
#undef PG8_SB
#undef PG8_STAGE
#undef PG8_LDA
#undef PG8_LDB
#undef PG8_MMA
#undef PG8_WAIT_V
#undef PG8_WAIT_L
#undef PG8_WAIT_VE
#undef PG8_BAR
#undef PG8_SCHED
}

template <class Epi, class Sched>
__device__ __forceinline__ void gemm_phase_gather(LAS unsigned char* lds, const int K, const unsigned lda, const unsigned ldb, const Sched& S, const Epi& E, const char* Abase, const LAS int* lmap) {
    const int tid = tidx(), wid = __builtin_amdgcn_readfirstlane(tid >> 6), lane = tid & 63, wr = wid >> 2, wc = wid & 3, fr = lane & 15, fq = lane >> 4;
    const int nt = K / BK;
    unsigned voffB[2]; int RA[2]; unsigned CA2[2];
#pragma unroll
    for (int i = 0; i < 2; ++i) { int R, C; stage_rc(tid * 16 + i * 8192, R, C); const int Rb = Epi::PERM ? ((R & ~31) + perm32(R & 31)) : R;
        RA[i] = R; CA2[i] = (unsigned)C * 2u; voffB[i] = (unsigned)Rb * ldb + (unsigned)C * 2u; }
    unsigned gc[2][2], gn[2][2];
#define PG8_GOFF(dst, u) do { _Pragma("unroll") for (int h_ = 0; h_ < 2; ++h_) _Pragma("unroll") for (int i_ = 0; i_ < 2; ++i_) { \
        const unsigned r_ = (unsigned)lmap[(u) * 256 + h_ * 128 + RA[i_]]; dst[h_][i_] = r_ * lda + CA2[i_]; } } while (0)
#define PG8_STAGEA(bufoff, g2, kb) do { _Pragma("unroll") for (int _i = 0; _i < 2; ++_i) \
        __builtin_amdgcn_global_load_lds((const unsigned*)(Abase + (size_t)(kb) + (g2)[_i]), (LAS unsigned*)(lds + (bufoff) + ldsw + _i * 8192), 16, 0, 0); } while (0)
    const size_t kstep = (size_t)(BK * 2);
    const size_t hstepB = (size_t)HALF * ldb;
    const unsigned ldsw = (unsigned)wid * 1024u;
    const int aoff = lds_byte(wr * 64 + fr, fq * 8), boff = lds_byte(wc * 32 + fr, fq * 8);
#define PG8_SA(b, h) (((b) * 2 + (h)) * HTB)
#define PG8_SB(b, h) ((4 + (b) * 2 + (h)) * HTB)
#define PG8_STAGE(bufoff, gbase, voff) do { _Pragma("unroll") for (int _i = 0; _i < 2; ++_i) \
        __builtin_amdgcn_global_load_lds((const unsigned*)((const char*)(gbase) + (voff)[_i]), (LAS unsigned*)(lds + (bufoff) + ldsw + _i * 8192), 16, 0, 0); } while (0)
#define PG8_LDA(dst, b, h) do { _Pragma("unroll") for (int m = 0; m < 4; ++m) _Pragma("unroll") for (int k = 0; k < 2; ++k) dst[m][k] = *(const LAS bf16x8*)(lds + PG8_SA(b, h) + aoff + m * 2048 + k * 1024); } while (0)
#define PG8_LDB(dst, b, h) do { _Pragma("unroll") for (int n = 0; n < 2; ++n) _Pragma("unroll") for (int k = 0; k < 2; ++k) dst[n][k] = *(const LAS bf16x8*)(lds + PG8_SB(b, h) + boff + n * 2048 + k * 1024); } while (0)
#define PG8_MMA(ai, bj, At, Bt) do { __builtin_amdgcn_s_setprio(1); _Pragma("unroll") for (int m = 0; m < 4; ++m) _Pragma("unroll") for (int n = 0; n < 2; ++n) _Pragma("unroll") for (int k = 0; k < 2; ++k) \
        acc[ai][bj][m][n] = __builtin_amdgcn_mfma_f32_16x16x32_bf16(Bt[n][k], At[m][k], acc[ai][bj][m][n], 0, 0, 0); __builtin_amdgcn_s_setprio(0); } while (0)
#define PG8_WAIT_V(n) asm volatile("s_waitcnt vmcnt(" #n ")" ::: "memory")
#define PG8_WAIT_VE(relax) asm volatile("s_waitcnt vmcnt(%1)\n\ts_cmp_lg_u32 %0, 0\n\ts_cbranch_scc1 1f\n\ts_waitcnt vmcnt(6)\n1:" :: "s"(relax), "i"(6 + Epi::NST) : "memory", "scc")
#define PG8_WAIT_L(n) asm volatile("s_waitcnt lgkmcnt(" #n ")" ::: "memory")
#define PG8_BAR __builtin_amdgcn_s_barrier()
#define PG8_SCHED __builtin_amdgcn_sched_barrier(0)
    Unit cur, nxt; int ui = 0;
    if (!S.next(0, cur)) return;
    f32x4 acc[2][2][4][2];
#pragma unroll
    for (int a = 0; a < 2; ++a)
#pragma unroll
        for (int b = 0; b < 2; ++b)
#pragma unroll
            for (int m = 0; m < 4; ++m)
#pragma unroll
                for (int n = 0; n < 2; ++n) acc[a][b][m][n] = (f32x4){0.f, 0.f, 0.f, 0.f};
    bf16x8 At[4][2], B0[2][2], B1[2][2];
    const char* cB = cur.B; PG8_GOFF(gc, 0);
    PG8_STAGE(PG8_SB(0, 0), cB, voffB); PG8_STAGEA(PG8_SA(0, 0), gc[0], 0); PG8_STAGE(PG8_SB(0, 1), cB + hstepB, voffB); PG8_STAGEA(PG8_SA(0, 1), gc[1], 0);
    if (wr == 1) PG8_BAR;
    PG8_WAIT_V(4); PG8_BAR;
    PG8_STAGE(PG8_SB(1, 0), cB + kstep, voffB); PG8_STAGEA(PG8_SA(1, 0), gc[0], kstep); PG8_STAGE(PG8_SB(1, 1), cB + hstepB + kstep, voffB); PG8_STAGEA(PG8_SA(1, 1), gc[1], kstep);
    PG8_WAIT_V(8); PG8_BAR;
    for (;;) {
        const bool has_next = S.next(ui + 1, nxt);
        const char* nB = has_next ? nxt.B : cB;
        if (has_next) PG8_GOFF(gn, ui + 1); else { gn[0][0] = gc[0][0]; gn[0][1] = gc[0][1]; gn[1][0] = gc[1][0]; gn[1][1] = gc[1][1]; }
        for (int t = 0; t < nt; t += 2) {
            const bool last = (t == nt - 2);
            const size_t ka2 = last ? (size_t)0 : (size_t)(t + 2) * kstep, ka3 = ka2 + kstep;
            unsigned g2[2][2];
#pragma unroll
            for (int h_ = 0; h_ < 2; ++h_)
#pragma unroll
                for (int i_ = 0; i_ < 2; ++i_) g2[h_][i_] = last ? gn[h_][i_] : gc[h_][i_];
            const char* b2 = last ? nB : cB + (size_t)(t + 2) * kstep; const char* b3 = b2 + kstep;
            PG8_LDB(B0, 0, 0); PG8_SCHED; PG8_LDA(At, 0, 0);
            PG8_WAIT_L(8); PG8_BAR; PG8_WAIT_L(0); PG8_MMA(0, 0, At, B0); PG8_BAR; PG8_SCHED;
            PG8_LDB(B1, 0, 1); PG8_STAGE(PG8_SB(0, 0), b2, voffB);
            PG8_BAR; PG8_WAIT_L(0); PG8_MMA(0, 1, At, B1); PG8_BAR;
            PG8_LDA(At, 0, 1); PG8_STAGEA(PG8_SA(0, 0), g2[0], ka2);
            PG8_BAR; PG8_WAIT_L(0); PG8_MMA(1, 0, At, B0); PG8_BAR; PG8_SCHED;
            PG8_STAGE(PG8_SB(0, 1), b2 + hstepB, voffB);
            PG8_WAIT_VE(__builtin_amdgcn_readfirstlane((int)(t == 0 && ui != 0)));
            PG8_BAR; PG8_MMA(1, 1, At, B1); PG8_BAR;
            PG8_LDB(B0, 1, 0); PG8_SCHED; PG8_LDA(At, 1, 0); PG8_STAGEA(PG8_SA(0, 1), g2[1], ka2);
            PG8_WAIT_L(8); PG8_BAR; PG8_WAIT_L(0); PG8_MMA(0, 0, At, B0); PG8_BAR; PG8_SCHED;
            PG8_LDB(B1, 1, 1); PG8_STAGE(PG8_SB(1, 0), b3, voffB);
            PG8_BAR; PG8_WAIT_L(0); PG8_MMA(0, 1, At, B1); PG8_BAR;
            PG8_LDA(At, 1, 1); PG8_STAGEA(PG8_SA(1, 0), g2[0], ka3);
            PG8_BAR; PG8_WAIT_L(0); PG8_MMA(1, 0, At, B0); PG8_BAR; PG8_SCHED;
            PG8_STAGE(PG8_SB(1, 1), b3 + hstepB, voffB);
            PG8_WAIT_V(6); PG8_BAR; PG8_MMA(1, 1, At, B1); PG8_BAR;
            PG8_STAGEA(PG8_SA(1, 1), g2[1], ka3);
            asm volatile("" ::: "memory");
        }
        E(acc, cur, wr, wc, fr, fq);
        if (!has_next) break;
#pragma unroll
        for (int a = 0; a < 2; ++a)
#pragma unroll
            for (int b = 0; b < 2; ++b)
#pragma unroll
                for (int m = 0; m < 4; ++m)
#pragma unroll
                    for (int n = 0; n < 2; ++n) acc[a][b][m][n] = (f32x4){0.f, 0.f, 0.f, 0.f};
        cur = nxt; cB = nB; ++ui; gc[0][0] = gn[0][0]; gc[0][1] = gn[0][1]; gc[1][0] = gn[1][0]; gc[1][1] = gn[1][1];
    }
    PG8_WAIT_V(0);
    if (wr == 0) PG8_BAR;
    PG8_BAR;
#undef PG8_SA
#undef PG8_SB
#undef PG8_STAGE
#undef PG8_STAGEA
#undef PG8_GOFF
#undef PG8_LDA
#undef PG8_LDB
#undef PG8_MMA
#undef PG8_WAIT_V
#undef PG8_WAIT_L
#undef PG8_WAIT_VE
#undef PG8_BAR
#undef PG8_SCHED
}

struct DenseOrder {
    int nM, nN, nwg, G, c, ashift; const char* A0; size_t astride; const char* B; unsigned lda, ldb;
    __device__ __forceinline__ bool next(int i, Unit& u) const {
        const long Lx = (long)i * G + c; if (Lx >= nwg) return false;
        const int wgid = xcd_remap((int)Lx, nwg);
        const int nig = WGM * nN, gid = wgid / nig, fm = gid * WGM, gsz = (nM - fm) < WGM ? (nM - fm) : WGM;
        u.pm = fm + ((wgid % nig) % gsz); u.pn = (wgid % nig) / gsz;
        const char* Ab = A0 + (size_t)(u.pn >> ashift) * astride;
        u.A = Ab + (size_t)u.pm * BM * lda; u.B = B + (size_t)u.pn * BM * ldb; return true;
    }
};
struct MoeOrder {
    int ntiles, nN, nwg, G, c; const LAS int* tile_e; const char* A; const char* B; unsigned lda, ldb; size_t bstride;
    __device__ __forceinline__ int pm_of(int i) const { const long Lx = (long)i * G + c; if (Lx >= nwg) return -1; return xcd_remap((int)Lx, nwg) / nN; }
    __device__ __forceinline__ bool next(int i, Unit& u) const {
        const long Lx = (long)i * G + c; if (Lx >= nwg) return false;
        const int wgid = xcd_remap((int)Lx, nwg);
        u.pm = wgid / nN; u.pn = wgid % nN;
        const int e = tile_e[u.pm];
        u.A = A + (size_t)u.pm * BM * lda; u.B = B + (size_t)e * bstride + (size_t)u.pn * BM * ldb; return true;
    }
};

struct EpiBf16 {
    static constexpr bool PERM = true; static constexpr int NST = 16;
    bf16_t* O; int ldc;
    __device__ __forceinline__ void operator()(const f32x4 (&acc)[2][2][4][2], const Unit& u, int wr, int wc, int fr, int fq) const {
        const int row0 = u.pm * BM + wr * 64 + fr, col0 = u.pn * BM + wc * 32 + 8 * fq;
#pragma unroll
        for (int ai = 0; ai < 2; ++ai)
#pragma unroll
            for (int m = 0; m < 4; ++m) { bf16_t* rowp = O + (size_t)(row0 + ai * HALF + m * 16) * ldc + col0;
#pragma unroll
                for (int bj = 0; bj < 2; ++bj) { const f32x4 v0 = acc[ai][bj][m][0], v1 = acc[ai][bj][m][1];
                    u32x4 w; w.x = cvt_pk_bf16(v0[0], v0[1]); w.y = cvt_pk_bf16(v0[2], v0[3]); w.z = cvt_pk_bf16(v1[0], v1[1]); w.w = cvt_pk_bf16(v1[2], v1[3]);
                    *(u32x4*)(rowp + bj * HALF) = w; } }
    }
};
struct EpiBf16HM {
    static constexpr bool PERM = true; static constexpr int NST = 16;
    bf16_t* O;
    __device__ __forceinline__ void operator()(const f32x4 (&acc)[2][2][4][2], const Unit& u, int wr, int wc, int fr, int fq) const {
        const int row0 = u.pm * BM + wr * 64 + fr, cl = wc * 32 + 8 * fq;
#pragma unroll
        for (int ai = 0; ai < 2; ++ai)
#pragma unroll
            for (int m = 0; m < 4; ++m) {
#pragma unroll
                for (int bj = 0; bj < 2; ++bj) { const f32x4 v0 = acc[ai][bj][m][0], v1 = acc[ai][bj][m][1];
                    u32x4 w; w.x = cvt_pk_bf16(v0[0], v0[1]); w.y = cvt_pk_bf16(v0[2], v0[3]); w.z = cvt_pk_bf16(v1[0], v1[1]); w.w = cvt_pk_bf16(v1[2], v1[3]);
                    *(u32x4*)(O + ((size_t)(u.pn * 2 + bj) * LT + (size_t)(row0 + ai * HALF + m * 16)) * 128 + cl) = w; } }
    }
};
struct EpiGate {
    static constexpr bool PERM = true; static constexpr int NST = 16;
    bf16_t* O; int ldc; const bf16_t* Gt; int ldg;
    __device__ __forceinline__ void operator()(const f32x4 (&acc)[2][2][4][2], const Unit& u, int wr, int wc, int fr, int fq) const {
        const int br = u.pn >> 2, pnz = u.pn & 3;
        const int row0 = u.pm * BM + wr * 64 + fr, colz = pnz * BM + wc * 32 + 8 * fq, colg = br * 1024 + colz;
#pragma unroll
        for (int ai = 0; ai < 2; ++ai) {
            u32x4 g[4][2], p[4][2];
#pragma unroll
            for (int m = 0; m < 4; ++m) { const size_t r = (size_t)(row0 + ai * HALF + m * 16);
#pragma unroll
                for (int bj = 0; bj < 2; ++bj) { g[m][bj] = *(const u32x4*)(Gt + r * ldg + colg + bj * HALF); p[m][bj] = (br != 0) ? *(const u32x4*)(O + r * ldc + colz + bj * HALF) : (u32x4){0u, 0u, 0u, 0u}; } }
#pragma unroll
            for (int m = 0; m < 4; ++m) { const size_t r = (size_t)(row0 + ai * HALF + m * 16); bf16_t* rowp = O + r * ldc + colz;
#pragma unroll
                for (int bj = 0; bj < 2; ++bj) { const f32x4 v0 = acc[ai][bj][m][0], v1 = acc[ai][bj][m][1]; const u32x4 gg = g[m][bj], pp = p[m][bj];
                    const float z0 = v0[0] * sigmoidf_(bflo(gg.x)) + bflo(pp.x), z1 = v0[1] * sigmoidf_(bfhi(gg.x)) + bfhi(pp.x), z2 = v0[2] * sigmoidf_(bflo(gg.y)) + bflo(pp.y), z3 = v0[3] * sigmoidf_(bfhi(gg.y)) + bfhi(pp.y);
                    const float z4 = v1[0] * sigmoidf_(bflo(gg.z)) + bflo(pp.z), z5 = v1[1] * sigmoidf_(bfhi(gg.z)) + bfhi(pp.z), z6 = v1[2] * sigmoidf_(bflo(gg.w)) + bflo(pp.w), z7 = v1[3] * sigmoidf_(bfhi(gg.w)) + bfhi(pp.w);
                    u32x4 w; w.x = cvt_pk_bf16(z0, z1); w.y = cvt_pk_bf16(z2, z3); w.z = cvt_pk_bf16(z4, z5); w.w = cvt_pk_bf16(z6, z7);
                    *(u32x4*)(rowp + bj * HALF) = w; } } }
    }
};
struct MergeOrder {
    int nM, nsu, G, c; const char* A0; size_t astride; const char* B; unsigned lda, ldb;
    __device__ __forceinline__ bool next(int i, Unit& u) const {
        const int su = (i / 3) * G + c, br = i % 3; if (su >= nsu) return false;
        const int s2 = xcd_remap(su, nsu);
        u.pm = s2 >> 2; const int pnz = s2 & 3; u.pn = br * 4 + pnz;
        u.A = A0 + (size_t)br * astride + (size_t)u.pm * BM * lda; u.B = B + (size_t)u.pn * BM * ldb; return true;
    }
};
struct EpiF32 {
    static constexpr bool PERM = false; static constexpr int NST = 32;
    float* C; int ldc;
    __device__ __forceinline__ void operator()(const f32x4 (&acc)[2][2][4][2], const Unit& u, int wr, int wc, int fr, int fq) const {
        const int row0 = u.pm * BM + wr * 64 + fr, col0 = u.pn * BM + wc * 32 + 4 * fq;
#pragma unroll
        for (int ai = 0; ai < 2; ++ai)
#pragma unroll
            for (int m = 0; m < 4; ++m) { float* rowp = C + (size_t)(row0 + ai * HALF + m * 16) * ldc + col0;
#pragma unroll
                for (int bj = 0; bj < 2; ++bj)
#pragma unroll
                    for (int n = 0; n < 2; ++n) *(f32x4*)(rowp + bj * HALF + n * 16) = acc[ai][bj][m][n]; }
    }
};
struct EpiSwiglu {
    static constexpr bool PERM = true; static constexpr int NST = 8;
    bf16_t* O; const float* bgu; const LAS int* tile_e;
    __device__ __forceinline__ void operator()(const f32x4 (&acc)[2][2][4][2], const Unit& u, int wr, int wc, int fr, int fq) const {
        const int row0 = u.pm * BM + wr * 64 + fr, cl = wc * 32 + 8 * fq, hc = u.pn * 128 + cl;
        const float* bb = bgu + (size_t)tile_e[u.pm] * 2048 + hc;
        const f32x4 bg0 = *(const f32x4*)(bb), bg1 = *(const f32x4*)(bb + 4), bu0 = *(const f32x4*)(bb + 1024), bu1 = *(const f32x4*)(bb + 1028);
#pragma unroll
        for (int ai = 0; ai < 2; ++ai)
#pragma unroll
            for (int m = 0; m < 4; ++m) { bf16_t* rowp = O + (size_t)(row0 + ai * HALF + m * 16) * 1024 + hc;
                float a[8];
#pragma unroll
                for (int n = 0; n < 2; ++n)
#pragma unroll
                    for (int j = 0; j < 4; ++j) { const float gt = fminf(acc[ai][0][m][n][j] + (n ? bg1[j] : bg0[j]), 7.0f);
                        const float up = fminf(fmaxf(acc[ai][1][m][n][j] + (n ? bu1[j] : bu0[j]), -7.0f), 7.0f);
                        a[n * 4 + j] = (up + 1.0f) * (gt * sigmoidf_(1.702f * gt)); }
                u32x4 w; w.x = cvt_pk_bf16(a[0], a[1]); w.y = cvt_pk_bf16(a[2], a[3]); w.z = cvt_pk_bf16(a[4], a[5]); w.w = cvt_pk_bf16(a[6], a[7]);
                *(u32x4*)rowp = w; }
    }
};
struct EpiDown {
    static constexpr bool PERM = true; static constexpr int NST = 16;
    bf16_t* O; const float* bd; const LAS int* tile_e;
    __device__ __forceinline__ void operator()(const f32x4 (&acc)[2][2][4][2], const Unit& u, int wr, int wc, int fr, int fq) const {
        const int row0 = u.pm * BM + wr * 64 + fr, col0 = u.pn * BM + wc * 32 + 8 * fq;
        const float* bb = bd + (size_t)tile_e[u.pm] * 1024 + col0;
        f32x4 bv[2][2];
#pragma unroll
        for (int bj = 0; bj < 2; ++bj)
#pragma unroll
            for (int n = 0; n < 2; ++n) bv[bj][n] = *(const f32x4*)(bb + bj * HALF + 4 * n);
#pragma unroll
        for (int ai = 0; ai < 2; ++ai)
#pragma unroll
            for (int m = 0; m < 4; ++m) { bf16_t* rowp = O + (size_t)(row0 + ai * HALF + m * 16) * 1024 + col0;
#pragma unroll
                for (int bj = 0; bj < 2; ++bj) { const f32x4 v0 = acc[ai][bj][m][0] + bv[bj][0], v1 = acc[ai][bj][m][1] + bv[bj][1];
                    u32x4 w; w.x = cvt_pk_bf16(v0[0], v0[1]); w.y = cvt_pk_bf16(v0[2], v0[3]); w.z = cvt_pk_bf16(v1[0], v1[1]); w.w = cvt_pk_bf16(v1[2], v1[3]);
                    *(u32x4*)(rowp + bj * HALF) = w; } }
    }
};
}
typedef __attribute__((address_space(1))) unsigned char gu8_t;
__device__ __forceinline__ unsigned char* wsbase(const Params& P) { unsigned long long v = (unsigned long long)P.ws; asm volatile("" : "+s"(v)); return (unsigned char*)(gu8_t*)v; }
#define WSP(T, off) ((T*)(wsbase(P) + (off)))
__device__ __forceinline__ const float* mod_ptr(const Params& P, int layer, int set) { return WSP(const float, WS_MOD) + ((size_t)layer * 2 + set) * 6144; }
__device__ __forceinline__ unsigned char* wlayer(const Params& P, int layer) { return wsbase(P) + WS_W + (size_t)layer * W_LAYER; }

__device__ __forceinline__ void adaln_item(const Params& P, int item, char* shm) {
    const int layer = item / 96, cg = item % 96, tid = tidx(), wid = tid >> 6, lane = tid & 63, col = cg * 64 + lane;
    const float* W = P.ada_w + (size_t)layer * 1024 * 6144 + col;
    float a0 = 0.f, a1 = 0.f;
#pragma unroll 8
    for (int k = wid * 128; k < wid * 128 + 128; ++k) {
        const float w = W[(size_t)k * 6144];
        const float c0 = P.c[k], c1 = P.c_ctx[k];
        a0 += (c0 / (1.0f + __expf(-c0))) * w; a1 += (c1 / (1.0f + __expf(-c1))) * w;
    }
    float* red = (float*)shm;
    red[(wid * 2 + 0) * 64 + lane] = a0; red[(wid * 2 + 1) * 64 + lane] = a1;
    __syncthreads();
    if (tid < 128) { const int set = tid >> 6; float s = 0.f;
#pragma unroll
        for (int w = 0; w < 8; ++w) s += red[(w * 2 + set) * 64 + lane];
        WSP(float, WS_MOD)[((size_t)layer * 2 + set) * 6144 + col] = s + P.ada_b[(size_t)layer * 6144 + col]; }
    __syncthreads();
}

struct ConvJob { const float* src; int srcK, srcN, ldsrc; bf16_t* dst; int lddst; int kind; };
__device__ __forceinline__ void conv_load(const ConvJob& J, int gk, int tn, int tid, f32x4 (&v)[8]) {
    const int k0 = gk * 256, n0 = tn * 64, r = tid >> 4, c = (tid & 15) * 4; const bool nok = (n0 + c) < J.srcN;
#pragma unroll
    for (int q = 0; q < 8; ++q) { const int k = k0 + r + 32 * q; v[q] = (f32x4){0.f, 0.f, 0.f, 0.f};
        if (nok && k < J.srcK) v[q] = *(const f32x4*)(J.src + (size_t)k * J.ldsrc + n0 + c); }
}
__device__ __forceinline__ void conv_store(const ConvJob& J, int gk, int tn, int tid, const f32x4 (&v)[8], char* shm) {
    float* tile = (float*)shm;
    const int k0 = gk * 256, n0 = tn * 64;
    { const int r = tid >> 4, c = (tid & 15) * 4;
#pragma unroll
      for (int q = 0; q < 8; ++q) { float* t = tile + (r + 32 * q) * 65 + c; t[0] = v[q][0]; t[1] = v[q][1]; t[2] = v[q][2]; t[3] = v[q][3]; } }
    __syncthreads();
    {
        const int nl = tid >> 3, n = n0 + nl; int drow = n; float sc = 1.0f;
        if (J.kind == 0) { if (n < 512) sc = 0.08838834764831845f; }
        if (J.kind == 5) { drow = (n < 1024) ? ((n >> 7) * 256 + (n & 127)) : (((n - 1024) >> 7) * 256 + 128 + ((n - 1024) & 127)); }
#pragma unroll
        for (int q = 0; q < 4; ++q) { const int kc = (tid & 7) * 8 + 64 * q; float w8[8];
#pragma unroll
            for (int j = 0; j < 8; ++j) w8[j] = tile[(kc + j) * 65 + nl] * sc;
            u32x4 w; w.x = cvt_pk_bf16(w8[0], w8[1]); w.y = cvt_pk_bf16(w8[2], w8[3]); w.z = cvt_pk_bf16(w8[4], w8[5]); w.w = cvt_pk_bf16(w8[6], w8[7]);
            bf16_t* d = J.dst + (size_t)drow * J.lddst + k0 + kc;
            *(u32x4*)d = w;
            if (J.kind == 4) { *(u32x4*)(d + 1024) = w; *(u32x4*)(d + 2048) = w; } }
    }
    __syncthreads();
}
__device__ __forceinline__ bool conv_lookup(const Params& P, int layer, long t, ConvJob& J, int& gk, int& tn) {
    unsigned char* wl = wlayer(P, layer);
    { const int GK = 4, TN = 112; const long n = (long)GK * TN; if (t < n) { J = ConvJob{P.w_in + (size_t)layer * 1024 * NIN, 1024, NIN, NIN, (bf16_t*)(wl + W_IN), 1024, 0}; gk = (int)(t % GK); tn = (int)(t / GK); return true; } t -= n; }
    { const int GK = 1, TN = 12; const long n = (long)GK * TN; if (t < n) { J = ConvJob{P.w_uq + (size_t)layer * 256 * 768, 256, 768, 768, (bf16_t*)(wl + W_UQ), 256, 1}; gk = (int)(t % GK); tn = (int)(t / GK); return true; } t -= n; }
    { const int GK = 1, TN = 16; const long n = (long)GK * TN; if (t < n) { J = ConvJob{P.w_ukv + (size_t)layer * 128 * 1024, 128, 1024, 1024, (bf16_t*)(wl + W_UKV), 256, 2}; gk = (int)(t % GK); tn = (int)(t / GK); return true; } t -= n; }
    { const int GK = 2, TN = 16; const long n = (long)GK * TN * 3; if (t < n) { const int b = (int)(t / (GK * TN)); const long tt = t % (GK * TN);
        J = ConvJob{P.w_branch + ((size_t)layer * 3 + b) * 512 * 1024, 512, 1024, 1024, (bf16_t*)(wl + W_BR) + (size_t)b * 1024 * 512, 512, 3}; gk = (int)(tt % GK); tn = (int)(tt / GK); return true; } t -= n; }
    { const int GK = 4, TN = 16; const long n = (long)GK * TN; if (t < n) { J = ConvJob{P.w_out + (size_t)layer * 1024 * 1024, 1024, 1024, 1024, (bf16_t*)(wl + W_OUT3), 3072, 4}; gk = (int)(t % GK); tn = (int)(t / GK); return true; } t -= n; }
    { const int GK = 4, TN = 32; const long n = (long)GK * TN * NE; if (t < n) { const int e = (int)(t / (GK * TN)); const long tt = t % (GK * TN);
        J = ConvJob{P.w_gu + ((size_t)layer * NE + e) * 1024 * 2048, 1024, 2048, 2048, (bf16_t*)(wl + W_GU) + (size_t)e * 2048 * 1024, 1024, 5}; gk = (int)(tt % GK); tn = (int)(tt / GK); return true; } t -= n; }
    { const int GK = 4, TN = 16; const long n = (long)GK * TN * NE; if (t < n) { const int e = (int)(t / (GK * TN)); const long tt = t % (GK * TN);
        J = ConvJob{P.w_down + ((size_t)layer * NE + e) * 1024 * 1024, 1024, 1024, 1024, (bf16_t*)(wl + W_DN) + (size_t)e * 1024 * 1024, 1024, 6}; gk = (int)(tt % GK); tn = (int)(tt / GK); return true; } t -= n; }
    return false;
}
constexpr long CONV_GROUPS = 4L * 112 + 12 + 16 + 96 + 64 + 128L * 32 + 64L * 32;

__device__ __forceinline__ void phase_p0(const Params& P, char* shm) {
    const int G = gridDim.x, b = blockIdx.x;
    if (b == 0 && tidx() < 256) { WSP(int, WS_CNT)[tidx()] = 0; }
    if (b == 1 && tidx() < 128) { ((u32x4*)(WSP(bf16_t, WS_H) + (size_t)LT * 1024))[tidx()] = (u32x4){0u, 0u, 0u, 0u}; }
    for (int it = b; it < 192; it += G) adaln_item(P, it, shm);
    {
        const int tid = tidx(); const long NG = CONV_GROUPS;
        ConvJob Jc, Jn; int gkc = 0, tnc = 0, gkn = 0, tnn = 0; f32x4 vc[8], vn[8];
        long t = b; bool have = t < NG;
        if (have) { (void)conv_lookup(P, (int)(t / CONV_GROUPS), t % CONV_GROUPS, Jc, gkc, tnc); conv_load(Jc, gkc, tnc, tid, vc); }
        while (have) {
            const long t2 = t + G; const bool hn = t2 < NG;
            if (hn) { (void)conv_lookup(P, (int)(t2 / CONV_GROUPS), t2 % CONV_GROUPS, Jn, gkn, tnn); conv_load(Jn, gkn, tnn, tid, vn); }
            conv_store(Jc, gkc, tnc, tid, vc, shm);
            if (hn) { Jc = Jn; gkc = gkn; tnc = tnn;
#pragma unroll
                for (int q = 0; q < 8; ++q) vc[q] = vn[q]; }
            t = t2; have = hn;
        }
    }
}

constexpr int CQ_WORD = 200;
__device__ __forceinline__ void conv_pull(const Params& P, char* shm, int quota) {
    const int tid = tidx(); int* head = WSP(int, WS_CNT) + CQ_WORD; int* slot = (int*)(shm + 70000);
    const long NG = (long)(DEPTH - 1) * CONV_GROUPS;
    if (quota == 0) return;
    if (tid == 0) *slot = atomicAdd(head, 1);
    __syncthreads();
    for (int n = 0; quota < 0 || n < quota; ++n) {
        const long t = *slot;
        __syncthreads();
        if (t >= NG) break;
        const bool more = (quota < 0 || n + 1 < quota);
        int tk = 0x7fffffff;
        if (more && tid == 0) tk = atomicAdd(head, 1);
        ConvJob J; int gk, tn; f32x4 v[8];
        (void)conv_lookup(P, 1 + (int)(t / CONV_GROUPS), t % CONV_GROUPS, J, gk, tn);
        conv_load(J, gk, tn, tid, v); conv_store(J, gk, tn, tid, v, shm);
        if (!more) break;
        if (tid == 0) *slot = tk;
        __syncthreads();
    }
}
__device__ __forceinline__ int units_of(int nwg, int G, int c) { return c < nwg ? (nwg - c + G - 1) / G : 0; }

__device__ __forceinline__ const float* xrow_in(const Params& P, int layer, int r) {
    if (layer == 0) return r < L ? P.x + (size_t)r * 1024 : P.ctx + (size_t)(r - L) * 1024;
    return WSP(const float, WS_X) + (size_t)r * 1024;
}

__device__ __forceinline__ void phase_modulate1(const Params& P, int layer) {
    const int lane = tidx() & 63, gw = blockIdx.x * 8 + (tidx() >> 6), nw = gridDim.x * 8;
    const float* g0 = P.norm_g + ((size_t)layer * 4 + 0) * 1024;
    bf16_t* H = WSP(bf16_t, WS_H);
    for (int r = gw; r < LT; r += nw) {
        const float* xr = xrow_in(P, layer, r); const float* md = mod_ptr(P, layer, r < L ? 0 : 1);
        f32x4 v[4]; float ss = 0.f;
#pragma unroll
        for (int i = 0; i < 4; ++i) { v[i] = *(const f32x4*)(xr + i * 256 + lane * 4); ss += v[i][0] * v[i][0] + v[i][1] * v[i][1] + v[i][2] * v[i][2] + v[i][3] * v[i][3]; }
        ss = wave_sum(ss); const float rs = rsqrtf(ss * (1.0f / 1024.0f) + EPS);
#pragma unroll
        for (int i = 0; i < 4; ++i) { const int c = i * 256 + lane * 4; const f32x4 g = *(const f32x4*)(g0 + c), sh = *(const f32x4*)(md + c), sc = *(const f32x4*)(md + 1024 + c);
            float o[4];
#pragma unroll
            for (int j = 0; j < 4; ++j) o[j] = v[i][j] * rs * g[j] * (1.0f + sc[j]) + sh[j];
            u32x2 w; w.x = cvt_pk_bf16(o[0], o[1]); w.y = cvt_pk_bf16(o[2], o[3]); *(u32x2*)(H + (size_t)r * 1024 + c) = w; }
    }
}

struct PrepRow { float g; u32x2 cq; unsigned ckv; float k1, k2; u32x2 da, db; u32x4 dv; };
__device__ __forceinline__ void prep_load(PrepRow& q, const bf16_t* Y, int r, int lane) {
    const bf16_t* y = Y + (size_t)r * NINP;
    q.g = (lane < 16) ? bf2f(y[C_MG + lane]) : 0.f;
    q.cq = *(const u32x2*)(y + C_CQ + lane * 4);
    q.ckv = *(const unsigned*)(y + C_CKV + lane * 2);
    q.k1 = (lane < 16) ? bf2f(y[C_KPE + lane]) : 0.f; q.k2 = (lane < 16) ? bf2f(y[C_KPE + 16 + lane]) : 0.f;
    { const int hh = lane >> 3, j0 = (lane & 7) * 4; const bf16_t* src = y + C_DK + hh * 64 + j0; q.da = *(const u32x2*)src; q.db = *(const u32x2*)(src + 32); }
    q.dv = *(const u32x4*)(y + C_DV + lane * 8);
}
__device__ __forceinline__ void phase_prep(const Params& P, int layer) {
    const int lane = tidx() & 63, gw = blockIdx.x * 8 + (tidx() >> 6), nw = gridDim.x * 8;
    const bf16_t* Y = WSP(const bf16_t, WS_Y);
    float* GT = WSP(float, WS_GATES); bf16_t* CQN = WSP(bf16_t, WS_CQN); bf16_t* CKVN = WSP(bf16_t, WS_CKVN); bf16_t* KPE = WSP(bf16_t, WS_KPE); bf16_t* KD = WSP(bf16_t, WS_KD);
    const float* qg = P.q_norm_g + (size_t)layer * 256; const float* kg = P.kv_norm_g + (size_t)layer * 128; const float* gb = P.m_gate_b + (size_t)layer * 16;
    PrepRow cur, nxt;
    if (gw < LT) prep_load(cur, Y, gw, lane);
    for (int r = gw; r < LT; r += nw) {
        if (r + nw < LT) prep_load(nxt, Y, r + nw, lane); else nxt = cur;
        const bool lat = r < L; const float prow = (float)(r >> 6), pcol = (float)(r & 63);
        if (lane < 16) { float g = cur.g + gb[lane];
            { const float e2 = __builtin_amdgcn_exp2f(g * (2.0f / 15.0f * 1.4426950408889634f)); g = 15.0f * (1.0f - 2.0f * __builtin_amdgcn_rcpf(e2 + 1.0f)); }
            const int type = lane >> 2; if (type & 1) g = fminf(g, 0.f) - __logf(1.0f + __expf(-fabsf(g)));
            GT[(size_t)r * 16 + lane] = g; }
        { const u32x2 w = cur.cq; float v[4] = {bflo(w.x), bfhi(w.x), bflo(w.y), bfhi(w.y)};
          float ss = v[0] * v[0] + v[1] * v[1] + v[2] * v[2] + v[3] * v[3]; ss = wave_sum(ss); const float rs = rsqrtf(ss * (1.0f / 256.0f) + EPS);
          const f32x4 g = *(const f32x4*)(qg + lane * 4); u32x2 o; o.x = cvt_pk_bf16(v[0] * rs * g[0], v[1] * rs * g[1]); o.y = cvt_pk_bf16(v[2] * rs * g[2], v[3] * rs * g[3]);
          *(u32x2*)(CQN + (size_t)r * 256 + lane * 4) = o; }
        { const unsigned w = cur.ckv; float v0 = bflo(w), v1 = bfhi(w);
          float ss = v0 * v0 + v1 * v1; ss = wave_sum(ss); const float rs = rsqrtf(ss * (1.0f / 128.0f) + EPS);
          const f32x2 g = *(const f32x2*)(kg + lane * 2);
          *(unsigned*)(CKVN + (size_t)r * 256 + lane * 2) = cvt_pk_bf16(v0 * rs * g[0], v1 * rs * g[1]);
          *(unsigned*)(CKVN + (size_t)r * 256 + 128 + lane * 2) = 0u; }
        if (lane < 16) { const float x1 = cur.k1, x2 = cur.k2; float o1 = x1, o2 = x2;
            if (lat) { const int t = lane & 7; const float inv = exp2f(-(float)t * (13.287712379549449f / 8.0f)); const float ang = (lane < 8 ? prow : pcol) * inv;
                float s, c; sincos_rev(ang, s, c); o1 = x1 * c - x2 * s; o2 = x1 * s + x2 * c; }
            KPE[(size_t)r * 32 + lane] = f2bf(o1); KPE[(size_t)r * 32 + 16 + lane] = f2bf(o2); }
        { const int hh = lane >> 3, j0 = (lane & 7) * 4;
          const u32x2 a = cur.da, b = cur.db;
          float x1[4] = {bflo(a.x), bfhi(a.x), bflo(a.y), bfhi(a.y)}, x2[4] = {bflo(b.x), bfhi(b.x), bflo(b.y), bfhi(b.y)}, o1[4], o2[4];
#pragma unroll
          for (int i = 0; i < 4; ++i) { o1[i] = x1[i]; o2[i] = x2[i];
              if (lat) { const int j = j0 + i, t = j & 15; const float inv = exp2f(-(float)t * (13.287712379549449f / 16.0f)); const float ang = (j < 16 ? prow : pcol) * inv;
                  float s, c; sincos_rev(ang, s, c); o1[i] = x1[i] * c - x2[i] * s; o2[i] = x1[i] * s + x2[i] * c; } }
          u32x2 w1, w2; w1.x = cvt_pk_bf16(o1[0], o1[1]); w1.y = cvt_pk_bf16(o1[2], o1[3]); w2.x = cvt_pk_bf16(o2[0], o2[1]); w2.y = cvt_pk_bf16(o2[2], o2[3]);
          bf16_t* dst = KD + ((size_t)(hh >> 1) * LT + (size_t)r) * 256 + (hh & 1) * 64 + j0; *(u32x2*)dst = w1; *(u32x2*)(dst + 32) = w2; }
        *(u32x4*)(KD + ((size_t)(lane >> 4) * LT + (size_t)r) * 256 + 128 + (lane & 15) * 8) = cur.dv;
        cur = nxt;
    }
}

constexpr int RT_STRIDE = 1028;
__device__ __forceinline__ void phase_postmix(const Params& P, int layer, char* shm) {
    const int tid = tidx(), wid = tid >> 6, lane = tid & 63;
    float* h2s = (float*)shm;
    float* lg = (float*)(shm + 32 * RT_STRIDE * 4);
    int* hist = (int*)(shm + 32 * RT_STRIDE * 4 + 32 * 33 * 4);
    const float* g1 = P.norm_g + ((size_t)layer * 4 + 1) * 1024; const float* g2 = P.norm_g + ((size_t)layer * 4 + 2) * 1024;
    const float* rw = P.router_w + (size_t)layer * 1024 * NE; const float* rb = P.router_b + (size_t)layer * NE;
    const bf16_t* YM = WSP(const bf16_t, WS_YMIX); float* X = WSP(float, WS_X); bf16_t* H = WSP(bf16_t, WS_H);
    int* TOPE = WSP(int, WS_TOPE); float* TOPW = WSP(float, WS_TOPW); int* POS = WSP(int, WS_POS); int* cnt = WSP(int, WS_CNT) + layer * 64;
    const int nrows = (layer == DEPTH - 1) ? L : LT;
    for (int it = blockIdx.x; it < nrows / 32; it += gridDim.x) {
        const int r0 = it * 32;
        for (int hp = 0; hp < 2; ++hp) {
            f32x4 v[2][4], xv[2][4]; float ss[2], s2[2], rs[2], rs2[2];
#pragma unroll
            for (int q = 0; q < 2; ++q) { const int r = r0 + wid * 4 + hp * 2 + q;
                const float* xr = xrow_in(P, layer, r); const bf16_t* yr = YM + (size_t)r * 1024;
#pragma unroll
                for (int i = 0; i < 4; ++i) { const u32x2 yw = *(const u32x2*)(yr + i * 256 + lane * 4); v[q][i] = (f32x4){bflo(yw.x), bfhi(yw.x), bflo(yw.y), bfhi(yw.y)};
                    xv[q][i] = *(const f32x4*)(xr + i * 256 + lane * 4); } }
#pragma unroll
            for (int q = 0; q < 2; ++q) { float s = 0.f;
#pragma unroll
                for (int i = 0; i < 4; ++i) s += v[q][i][0] * v[q][i][0] + v[q][i][1] * v[q][i][1] + v[q][i][2] * v[q][i][2] + v[q][i][3] * v[q][i][3];
                ss[q] = s; }
#pragma unroll
            for (int q = 0; q < 2; ++q) ss[q] = wave_sum(ss[q]);
            f32x4 pg1[4], pga[4];
            { const float* mdq_ = mod_ptr(P, layer, r0 < L ? 0 : 1);
#pragma unroll
              for (int i = 0; i < 4; ++i) { const int c = i * 256 + lane * 4; pg1[i] = *(const f32x4*)(g1 + c); pga[i] = *(const f32x4*)(mdq_ + 2048 + c); }
#pragma unroll
              for (int i = 0; i < 4; ++i) asm volatile("" : "+v"(pg1[i]), "+v"(pga[i])); }
#pragma unroll
            for (int q = 0; q < 2; ++q) { rs[q] = rsqrtf(ss[q] * (1.0f / 1024.0f) + EPS); const int r = r0 + wid * 4 + hp * 2 + q; float s = 0.f;
#pragma unroll
                for (int i = 0; i < 4; ++i) { const int c = i * 256 + lane * 4; const f32x4 g = pg1[i], ga = pga[i];
#pragma unroll
                    for (int j = 0; j < 4; ++j) { xv[q][i][j] += ga[j] * (v[q][i][j] * rs[q] * g[j]); s += xv[q][i][j] * xv[q][i][j]; }
                    *(f32x4*)(X + (size_t)r * 1024 + c) = xv[q][i]; }
                s2[q] = s; }
#pragma unroll
            for (int q = 0; q < 2; ++q) s2[q] = wave_sum(s2[q]);
            f32x4 pg2[4], psh[4], psc[4];
            { const float* mdq_ = mod_ptr(P, layer, r0 < L ? 0 : 1);
#pragma unroll
              for (int i = 0; i < 4; ++i) { const int c = i * 256 + lane * 4; pg2[i] = *(const f32x4*)(g2 + c); psh[i] = *(const f32x4*)(mdq_ + 3072 + c); psc[i] = *(const f32x4*)(mdq_ + 4096 + c); }
#pragma unroll
              for (int i = 0; i < 4; ++i) asm volatile("" : "+v"(pg2[i]), "+v"(psh[i]), "+v"(psc[i])); }
#pragma unroll
            for (int q = 0; q < 2; ++q) { rs2[q] = rsqrtf(s2[q] * (1.0f / 1024.0f) + EPS); const int rl = wid * 4 + hp * 2 + q, r = r0 + rl;
#pragma unroll
                for (int i = 0; i < 4; ++i) { const int c = i * 256 + lane * 4; const f32x4 g = pg2[i], sh = psh[i], sc = psc[i];
                    f32x4 o;
#pragma unroll
                    for (int j = 0; j < 4; ++j) o[j] = xv[q][i][j] * rs2[q] * g[j] * (1.0f + sc[j]) + sh[j];
                    *(f32x4*)(h2s + rl * RT_STRIDE + c) = o;
                    u32x2 w; w.x = cvt_pk_bf16(o[0], o[1]); w.y = cvt_pk_bf16(o[2], o[3]); *(u32x2*)(H + (size_t)r * 1024 + c) = w; } }
        }
        if (tid < 32) hist[tid] = 0;
        __syncthreads();
        f32x16 acc = {};
        { const int i = lane & 31, kh = lane >> 5, kb = wid * 128 + kh * 64;
          const float* ap = h2s + i * RT_STRIDE + kb; const float* bp = rw + (size_t)kb * NE + i;
          float bv[32], bw[32];
#define RW_PIN(a, b) asm volatile("" : "+v"(a[b + 0]), "+v"(a[b + 1]), "+v"(a[b + 2]), "+v"(a[b + 3]), "+v"(a[b + 4]), "+v"(a[b + 5]), "+v"(a[b + 6]), "+v"(a[b + 7]), \
                                      "+v"(a[b + 8]), "+v"(a[b + 9]), "+v"(a[b + 10]), "+v"(a[b + 11]), "+v"(a[b + 12]), "+v"(a[b + 13]), "+v"(a[b + 14]), "+v"(a[b + 15]))
#pragma unroll
          for (int s = 0; s < 32; ++s) bv[s] = bp[(size_t)s * NE];
          RW_PIN(bv, 0); RW_PIN(bv, 16);
#pragma unroll
          for (int s = 0; s < 32; ++s) bw[s] = bp[(size_t)(32 + s) * NE];
#pragma unroll
          for (int s = 0; s < 32; ++s) acc = __builtin_amdgcn_mfma_f32_32x32x2f32(ap[s], bv[s], acc, 0, 0, 0);
          RW_PIN(bw, 0); RW_PIN(bw, 16);
#pragma unroll
          for (int s = 0; s < 32; ++s) acc = __builtin_amdgcn_mfma_f32_32x32x2f32(ap[32 + s], bw[s], acc, 0, 0, 0);
#undef RW_PIN
        }
        __syncthreads();
        { float* part = h2s + wid * 1024;
#pragma unroll
          for (int rg = 0; rg < 16; ++rg) { const int row = (rg & 3) + 8 * (rg >> 2) + 4 * (lane >> 5); part[row * 32 + (lane & 31)] = acc[rg]; } }
        __syncthreads();
        for (int o = tid; o < 1024; o += NTHR) { float s = 0.f;
#pragma unroll
            for (int w = 0; w < 8; ++w) s += h2s[w * 1024 + o];
            lg[(o >> 5) * 33 + (o & 31)] = s + rb[o & 31]; }
        __syncthreads();
        int myE[4]; float myW[4]; int myRank[4];
        if (tid < 32) {
            float vals[4]; unsigned used = 0u; float lv[NE];
#pragma unroll
            for (int e = 0; e < NE; ++e) lv[e] = lg[tid * 33 + e];
#pragma unroll
            for (int k = 0; k < 4; ++k) { float best = -3.0e38f; int bi = 0;
#pragma unroll
                for (int e = 0; e < NE; ++e) { const float v = lv[e]; if (!((used >> e) & 1u) && v > best) { best = v; bi = e; } }
                used |= 1u << bi; vals[k] = best; myE[k] = bi; }
            float se = 0.f;
#pragma unroll
            for (int k = 0; k < 4; ++k) { myW[k] = __expf(vals[k] - vals[0]); se += myW[k]; }
#pragma unroll
            for (int k = 0; k < 4; ++k) { myW[k] /= se; myRank[k] = atomicAdd(&hist[myE[k]], 1); }
        }
        __syncthreads();
        if (tid < 32) { const int n = hist[tid]; int e_ = tid; asm volatile("" : "+v"(e_));
            hist[32 + tid] = n ? atomicAdd(&cnt[e_], n) : 0; }
        __syncthreads();
        if (tid < 32) { const int r = r0 + tid;
#pragma unroll
            for (int k = 0; k < 4; ++k) { TOPE[(size_t)r * 4 + k] = myE[k]; TOPW[(size_t)r * 4 + k] = myW[k]; POS[(size_t)r * 4 + k] = hist[32 + myE[k]] + myRank[k]; } }
        __syncthreads();
    }
}

__device__ __forceinline__ void phase_gather(const Params& P, int layer, char* shm) {
    const int tid = tidx(), wid = tid >> 6, lane = tid & 63;
    int* offs = (int*)shm;
    const int* cnt = WSP(const int, WS_CNT) + layer * 64; int* TI = WSP(int, WS_TILE) + layer * 512;
    if (tid < NE) offs[40 + tid] = (cnt[tid] + 255) & ~255;
    __syncthreads();
    if (tid == 0) { int o = 0; for (int e = 0; e < NE; ++e) { offs[e] = o; o += offs[40 + e]; } offs[32] = o; }
    __syncthreads();
    if (blockIdx.x == 0) {
        if (tid == 0) TI[0] = offs[32] >> 8;
        for (int t = tid; t < CAP_TILES; t += NTHR) { int e = 0; for (int q = 1; q < NE; ++q) if (t * 256 >= offs[q]) e = q; TI[64 + t] = e; }
    }
    int* SLOT_T = WSP(int, WS_XS);
    const int* TOPE = WSP(const int, WS_TOPE); int* POS = WSP(int, WS_POS);
    const int nrows = (layer == DEPTH - 1) ? L : LT;
    for (int i = blockIdx.x * NTHR + tid; i < nrows * 4; i += gridDim.x * NTHR) { const int slot = offs[TOPE[i]] + POS[i]; POS[i] = slot; SLOT_T[slot] = i >> 2; }
    if (blockIdx.x < NE) { const int e = blockIdx.x; for (int sl = offs[e] + cnt[e] + tid; sl < offs[e + 1]; sl += NTHR) SLOT_T[sl] = LT; }
}

__device__ __forceinline__ void phase_combine(const Params& P, int layer) {
    const int lane = tidx() & 63, gw = blockIdx.x * 8 + (tidx() >> 6), nw = gridDim.x * 8;
    const float* g3 = P.norm_g + ((size_t)layer * 4 + 3) * 1024;
    const bf16_t* YS = WSP(const bf16_t, WS_YS); float* X = WSP(float, WS_X); const int* POS = WSP(const int, WS_POS); const float* TOPW = WSP(const float, WS_TOPW);
    const bool lastl = (layer == DEPTH - 1); const int nrows = lastl ? L : LT;
    u32x4 ca[4], cb[4], na[4], nb[4]; float cw[4], nwt[4]; f32x4 cx[4], nx[4];
#define LOADROW(r_, A_, B_, W_, XV_) do { const f32x4 w4_ = *(const f32x4*)(TOPW + (size_t)(r_) * 4); const u32x4 s4_ = *(const u32x4*)(POS + (size_t)(r_) * 4); \
        W_[0] = w4_[0]; W_[1] = w4_[1]; W_[2] = w4_[2]; W_[3] = w4_[3]; const unsigned sl_[4] = {s4_.x, s4_.y, s4_.z, s4_.w}; \
        _Pragma("unroll") for (int k = 0; k < 4; ++k) { A_[k] = *(const u32x4*)(YS + (size_t)sl_[k] * 1024 + lane * 8); B_[k] = *(const u32x4*)(YS + (size_t)sl_[k] * 1024 + 512 + lane * 8); } \
        _Pragma("unroll") for (int q = 0; q < 4; ++q) XV_[q] = *(const f32x4*)(X + (size_t)(r_) * 1024 + (q >> 1) * 512 + lane * 8 + (q & 1) * 4); } while (0)
    int r = gw;
    if (r < nrows) LOADROW(r, ca, cb, cw, cx);
    for (; r < nrows; r += nw) {
        const int r2 = r + nw; const bool hn = r2 < nrows;
        if (hn) LOADROW(r2, na, nb, nwt, nx);
        const float* md = mod_ptr(P, layer, r < L ? 0 : 1);
        float f[16];
#pragma unroll
        for (int j = 0; j < 16; ++j) f[j] = 0.f;
#pragma unroll
        for (int k = 0; k < 4; ++k) { const float w = cw[k]; const u32x4 a = ca[k], b = cb[k];
            f[0] += w * bflo(a.x); f[1] += w * bfhi(a.x); f[2] += w * bflo(a.y); f[3] += w * bfhi(a.y); f[4] += w * bflo(a.z); f[5] += w * bfhi(a.z); f[6] += w * bflo(a.w); f[7] += w * bfhi(a.w);
            f[8] += w * bflo(b.x); f[9] += w * bfhi(b.x); f[10] += w * bflo(b.y); f[11] += w * bfhi(b.y); f[12] += w * bflo(b.z); f[13] += w * bfhi(b.z); f[14] += w * bflo(b.w); f[15] += w * bfhi(b.w); }
        float ss = 0.f;
#pragma unroll
        for (int j = 0; j < 16; ++j) ss += f[j] * f[j];
        ss = wave_sum(ss); const float rs = rsqrtf(ss * (1.0f / 1024.0f) + EPS);
        float* xo = lastl ? P.out + (size_t)r * 1024 : X + (size_t)r * 1024;
        float s2 = 0.f;
#pragma unroll
        for (int hlf = 0; hlf < 2; ++hlf) { const int c = hlf * 512 + lane * 8;
#pragma unroll
            for (int q = 0; q < 2; ++q) { const f32x4 xv = cx[hlf * 2 + q], g = *(const f32x4*)(g3 + c + q * 4), ga = *(const f32x4*)(md + 5120 + c + q * 4);
                f32x4 o;
#pragma unroll
                for (int j = 0; j < 4; ++j) { o[j] = xv[j] + ga[j] * (f[hlf * 8 + q * 4 + j] * rs * g[j]); f[hlf * 8 + q * 4 + j] = o[j]; s2 += o[j] * o[j]; }
                *(f32x4*)(xo + c + q * 4) = o; } }
        if (!lastl) {
            s2 = wave_sum(s2); const float rs2 = rsqrtf(s2 * (1.0f / 1024.0f) + EPS);
            const float* g0n = P.norm_g + ((size_t)(layer + 1) * 4 + 0) * 1024; const float* mdn = mod_ptr(P, layer + 1, r < L ? 0 : 1); bf16_t* H = WSP(bf16_t, WS_H);
#pragma unroll
            for (int hlf = 0; hlf < 2; ++hlf) { const int c = hlf * 512 + lane * 8; float hv[8];
#pragma unroll
                for (int q = 0; q < 2; ++q) { const f32x4 g = *(const f32x4*)(g0n + c + q * 4), sh = *(const f32x4*)(mdn + c + q * 4), sc = *(const f32x4*)(mdn + 1024 + c + q * 4);
#pragma unroll
                    for (int j = 0; j < 4; ++j) hv[q * 4 + j] = f[hlf * 8 + q * 4 + j] * rs2 * g[j] * (1.0f + sc[j]) + sh[j]; }
                u32x4 w; w.x = cvt_pk_bf16(hv[0], hv[1]); w.y = cvt_pk_bf16(hv[2], hv[3]); w.z = cvt_pk_bf16(hv[4], hv[5]); w.w = cvt_pk_bf16(hv[6], hv[7]);
                *(u32x4*)(H + (size_t)r * 1024 + c) = w; } }
        if (hn) {
#pragma unroll
            for (int k = 0; k < 4; ++k) { ca[k] = na[k]; cb[k] = nb[k]; cw[k] = nwt[k]; cx[k] = nx[k]; } }
    }
#undef LOADROW
}
#define KSWZ(row, colB) ((row) * 256 + ((colB) ^ ((((row) & 7) | ((((row) >> 4) & 1) << 3)) << 4)))
#define SBAR() __builtin_amdgcn_sched_barrier(0)
__device__ __forceinline__ int crow(int r, int hi) { return (r & 3) + 8 * (r >> 2) + 4 * hi; }
template <int NVB> __device__ __forceinline__ int v_st(int k, int c) { const int kk = (k & ~0xC) | ((k & 4) << 1) | ((k & 8) >> 1); return ((kk >> 3) * NVB + (c >> 5)) * 512 + ((kk & 7) * 32 + (c & 31)) * 2; }
__device__ __forceinline__ int v_rd_base(int lane) { return ((lane & 3) << 3) | (((lane >> 2) & 3) << 6) | (((lane >> 4) & 1) << 5) | (((lane >> 5) & 1) << 8); }
template <int NVB> constexpr int v_rd_off(int d0, int ks, int half) { return ((2 * ks + half) * NVB + d0) * 512; }
template <int OFF> __device__ __forceinline__ s16x4 tr_read(int vb) { s16x4 r; asm volatile("ds_read_b64_tr_b16 %0, %1 offset:%2" : "=&v"(r) : "v"(vb), "i"(OFF) : "memory"); return r; }
#define PKF(Lo, Hi) (bf16x8){Lo[0], Lo[1], Lo[2], Lo[3], Hi[0], Hi[1], Hi[2], Hi[3]}
__device__ __forceinline__ int lds_addr(const void* p) { return (int)(uintptr_t)p; }

__device__ __forceinline__ void partialSM(f32x16& p0, f32x16& p1, float& m_reg, float& mn, float& alpha, const float C, const float THRS) {
    float pmax = p0[0];
#pragma unroll
    for (int r = 1; r < 16; ++r) pmax = fmaxf(pmax, p0[r]);
#pragma unroll
    for (int r = 0; r < 16; ++r) pmax = fmaxf(pmax, p1[r]);
    { auto rr = __builtin_amdgcn_permlane32_swap(__float_as_uint(pmax), __float_as_uint(pmax), false, false); pmax = fmaxf(__uint_as_float(rr[0]), __uint_as_float(rr[1])); }
    if (__builtin_expect(__all(pmax - m_reg <= THRS), 1)) { mn = m_reg; alpha = 1.f; }
    else { mn = fmaxf(m_reg, pmax); alpha = __builtin_amdgcn_exp2f((m_reg - mn) * C); m_reg = mn; }
    const float mnC = -mn * C;
#pragma unroll
    for (int r = 0; r < 16; ++r) p0[r] = fmaf(p0[r], C, mnC);
#pragma unroll
    for (int r = 0; r < 16; ++r) p1[r] = fmaf(p1[r], C, mnC);
#pragma unroll
    for (int r = 0; r < 16; ++r) p0[r] = __builtin_amdgcn_exp2f(p0[r]);
}
#define PK4(Pv, BASE, OUT) do { unsigned a0 = cvt_pk_bf16(Pv[BASE + 0], Pv[BASE + 1]), a1 = cvt_pk_bf16(Pv[BASE + 2], Pv[BASE + 3]);   \
    unsigned b0 = cvt_pk_bf16(Pv[BASE + 4], Pv[BASE + 5]), b1 = cvt_pk_bf16(Pv[BASE + 6], Pv[BASE + 7]);                              \
    auto r0_ = __builtin_amdgcn_permlane32_swap(a0, b0, false, false); auto r1_ = __builtin_amdgcn_permlane32_swap(a1, b1, false, false); \
    u32x4 w_ = {r0_[0], r1_[0], r0_[1], r1_[1]}; OUT = *reinterpret_cast<bf16x8*>(&w_); } while (0)
__device__ __forceinline__ void finishSM(f32x16& p0, f32x16& p1, float alpha, float& l_reg, bf16x8& pa0, bf16x8& pa1, bf16x8& pa2, bf16x8& pa3) {
#pragma unroll
    for (int r = 0; r < 16; ++r) p1[r] = __builtin_amdgcn_exp2f(p1[r]);
    float ps = 0;
#pragma unroll
    for (int r = 0; r < 16; ++r) ps += p0[r];
#pragma unroll
    for (int r = 0; r < 16; ++r) ps += p1[r];
    { auto rr = __builtin_amdgcn_permlane32_swap(__float_as_uint(ps), __float_as_uint(ps), false, false); ps = __uint_as_float(rr[0]) + __uint_as_float(rr[1]); }
    l_reg = l_reg * alpha + ps;
    PK4(p0, 0, pa0); PK4(p0, 8, pa1); PK4(p1, 0, pa2); PK4(p1, 8, pa3);
}
template <int NKD> __device__ __forceinline__ void qkt(f32x16& p0, f32x16& p1, const char* Ks, const bf16x8* qr, int r32, int hi, int cb0) {
    p0 = f32x16{}; p1 = f32x16{};
#pragma unroll
    for (int d0 = 0; d0 < NKD; ++d0) { const int cb = cb0 + (d0 * 16 + hi * 8) * 2;
        const bf16x8 b0 = *reinterpret_cast<const bf16x8*>(Ks + KSWZ(r32, cb));
        const bf16x8 b1 = *reinterpret_cast<const bf16x8*>(Ks + KSWZ(32 + r32, cb));
        p0 = __builtin_amdgcn_mfma_f32_32x32x16_bf16(b0, qr[d0], p0, 0, 0, 0);
        p1 = __builtin_amdgcn_mfma_f32_32x32x16_bf16(b1, qr[d0], p1, 0, 0, 0); }
}
template <int NVB, int D0> __device__ __forceinline__ void pv_one(f32x16& od, int vb, bf16x8 pa0, bf16x8 pa1, bf16x8 pa2, bf16x8 pa3) {
    const s16x4 l0 = tr_read<v_rd_off<NVB>(D0, 0, 0)>(vb), h0 = tr_read<v_rd_off<NVB>(D0, 0, 1)>(vb), l1 = tr_read<v_rd_off<NVB>(D0, 1, 0)>(vb), h1 = tr_read<v_rd_off<NVB>(D0, 1, 1)>(vb);
    const s16x4 l2 = tr_read<v_rd_off<NVB>(D0, 2, 0)>(vb), h2 = tr_read<v_rd_off<NVB>(D0, 2, 1)>(vb), l3 = tr_read<v_rd_off<NVB>(D0, 3, 0)>(vb), h3 = tr_read<v_rd_off<NVB>(D0, 3, 1)>(vb);
    asm volatile("s_waitcnt lgkmcnt(0)" ::: "memory"); SBAR();
    od = __builtin_amdgcn_mfma_f32_32x32x16_bf16(pa0, PKF(l0, h0), od, 0, 0, 0);
    od = __builtin_amdgcn_mfma_f32_32x32x16_bf16(pa1, PKF(l1, h1), od, 0, 0, 0);
    od = __builtin_amdgcn_mfma_f32_32x32x16_bf16(pa2, PKF(l2, h2), od, 0, 0, 0);
    od = __builtin_amdgcn_mfma_f32_32x32x16_bf16(pa3, PKF(l3, h3), od, 0, 0, 0);
}

template <bool DIFF>
__device__ __forceinline__ void attn_unit(const Params& P, int layer, char* lds, int head, int qrow0, int key0, int nkeys) {
    constexpr int NKD = DIFF ? 4 : 6, NVB = DIFF ? 4 : 2;
    constexpr int SHM_K = 64 * 256, SHM_V = 64 * NVB * 64;
    constexpr float SCALE = DIFF ? 0.125f : 0.10206207261596577f;
    constexpr float C = SCALE * 1.4426950408889634f, THRS = 8.0f / SCALE;
    const int tid = tidx(), wid = tid >> 6, lane = tid & 63, r32 = lane & 31, hi = lane >> 5;
    char* V_lds = lds; char* K_lds = lds + 2 * SHM_V;
    float* wsf = (float*)(lds + 2 * SHM_V + 2 * SHM_K) + wid * 64; float* li_l = wsf; float* al_l = wsf + 32;
    const int map = DIFF ? (wid >> 2) : 0, wrow = DIFF ? (wid & 3) * 32 : wid * 32;
    const int qrow = qrow0 + wrow + r32;
    const bf16_t* Y = WSP(const bf16_t, WS_Y); const bf16_t* KD = WSP(const bf16_t, WS_KD); const bf16_t* KVR = WSP(const bf16_t, WS_KVRAW); const bf16_t* KPE = WSP(const bf16_t, WS_KPE);
    bf16x8 qr[NKD];
    { const bf16_t* qsrc = DIFF ? (Y + (size_t)qrow * NINP + C_DQ + (2 * head + map) * 64 + hi * 8) : (WSP(const bf16_t, WS_QRAW) + (size_t)qrow * 768 + head * 96 + hi * 8);
#pragma unroll
      for (int d0 = 0; d0 < NKD; ++d0) qr[d0] = *reinterpret_cast<const bf16x8*>(qsrc + d0 * 16);
      if (qrow < L) { const float prow = (float)(qrow >> 6), pcol = (float)(qrow & 63);
          if (DIFF) {
#pragma unroll
              for (int d0 = 0; d0 < 2; ++d0)
#pragma unroll
                  for (int i = 0; i < 8; ++i) { const int t = hi * 8 + i; const float inv = exp2f(-(float)t * (13.287712379549449f / 16.0f)); const float ang = (d0 == 0 ? prow : pcol) * inv;
                      float s, c; sincos_rev(ang, s, c); const float x1 = bf2f((bf16_t)qr[d0][i]), x2 = bf2f((bf16_t)qr[d0 + 2][i]);
                      qr[d0][i] = (short)f2bf(x1 * c - x2 * s); qr[d0 + 2][i] = (short)f2bf(x1 * s + x2 * c); }
          } else {
#pragma unroll
              for (int i = 0; i < 8; ++i) { const float inv = exp2f(-(float)i * (13.287712379549449f / 8.0f)); const float ang = (hi == 0 ? prow : pcol) * inv;
                  float s, c; sincos_rev(ang, s, c); const float x1 = bf2f((bf16_t)qr[NKD - 2][i]), x2 = bf2f((bf16_t)qr[NKD - 1][i]);
                  qr[NKD - 2][i] = (short)f2bf(x1 * c - x2 * s); qr[NKD - 1][i] = (short)f2bf(x1 * s + x2 * c); }
          } } }
    const bf16_t *ksrc0, *ksrc1, *vsrc0, *vsrc1; size_t kstr, vstr; int kdst0, kdst1, vdst0, vdst1; bool k1on, v1on;
    if (DIFF) { const int sr = tid >> 4, sc = (tid & 15) * 8;
        ksrc0 = KD + (size_t)(key0 + sr) * 512 + head * 128 + sc; ksrc1 = ksrc0 + (size_t)32 * 512; kstr = 512;
        vsrc0 = Y + (size_t)(key0 + sr) * NINP + C_DV + head * 128 + sc; vsrc1 = vsrc0 + (size_t)32 * NINP; vstr = NINP;
        kdst0 = KSWZ(sr, sc * 2); kdst1 = KSWZ(32 + sr, sc * 2); vdst0 = v_st<NVB>(sr, sc); vdst1 = v_st<NVB>(32 + sr, sc); k1on = true; v1on = true;
    } else {
        { const int g = tid, row = g / 12, gi = g % 12;
          ksrc0 = gi < 8 ? KVR + (size_t)(key0 + row) * 1024 + head * 128 + gi * 8 : KPE + (size_t)(key0 + row) * 32 + (gi - 8) * 8; kdst0 = KSWZ(row, gi * 16); }
        { const int g = 512 + (tid & 255), row = g / 12, gi = g % 12;
          ksrc1 = gi < 8 ? KVR + (size_t)(key0 + row) * 1024 + head * 128 + gi * 8 : KPE + (size_t)(key0 + row) * 32 + (gi - 8) * 8; kdst1 = KSWZ(row, gi * 16); }
        kstr = 0;
        { const int row = tid >> 3, gi = tid & 7; vsrc0 = KVR + (size_t)(key0 + row) * 1024 + head * 128 + 64 + gi * 8; vdst0 = v_st<NVB>(row, gi * 8); }
        vsrc1 = vsrc0; vdst1 = vdst0; vstr = 1024; k1on = tid < 256; v1on = false;
    }
    size_t ks0 = kstr, ks1 = kstr;
    if (!DIFF) { ks0 = ((tid % 12) < 8) ? 1024 : 32; ks1 = (((512 + (tid & 255)) % 12) < 8) ? 1024 : 32; }
    bf16x8 sk0, sk1, sv0, sv1;
#define SLOAD(k0) do { sk0 = *reinterpret_cast<const bf16x8*>(ksrc0 + (size_t)(k0) * ks0); if (k1on) sk1 = *reinterpret_cast<const bf16x8*>(ksrc1 + (size_t)(k0) * ks1); \
        sv0 = *reinterpret_cast<const bf16x8*>(vsrc0 + (size_t)(k0) * vstr); if (v1on) sv1 = *reinterpret_cast<const bf16x8*>(vsrc1 + (size_t)(k0) * vstr); } while (0)
#define SWRITE(b) do { *reinterpret_cast<bf16x8*>(K_lds + (b) * SHM_K + kdst0) = sk0; if (k1on) *reinterpret_cast<bf16x8*>(K_lds + (b) * SHM_K + kdst1) = sk1; \
        *reinterpret_cast<bf16x8*>(V_lds + (b) * SHM_V + vdst0) = sv0; if (v1on) *reinterpret_cast<bf16x8*>(V_lds + (b) * SHM_V + vdst1) = sv1; } while (0)
#define SWAIT() asm volatile("s_waitcnt vmcnt(0)" ::: "memory")
#define RESC(a) do { if (__any((a) < 1.f)) { if (hi == 0) al_l[r32] = (a); asm volatile("s_waitcnt lgkmcnt(0)" ::: "memory"); \
        _Pragma("unroll") for (int d = 0; d < NVB; ++d) _Pragma("unroll") for (int r = 0; r < 16; ++r) o[d][r] *= al_l[crow(r, hi)]; } } while (0)
#define PVALL(vb) do { pv_one<NVB, 0>(o[0], vb, pa0, pa1, pa2, pa3); pv_one<NVB, 1>(o[1], vb, pa0, pa1, pa2, pa3); \
        if constexpr (NVB == 4) { pv_one<NVB, 2>(o[2], vb, pa0, pa1, pa2, pa3); pv_one<NVB, 3>(o[3], vb, pa0, pa1, pa2, pa3); } } while (0)
    const int vb0 = lds_addr(V_lds) + v_rd_base(lane);
    const int cbq = DIFF ? map * 128 : 0;
    float m_reg = -1e30f, l_reg = 0; f32x16 o[NVB];
#pragma unroll
    for (int d = 0; d < NVB; ++d) o[d] = f32x16{};
    f32x16 pA0, pA1, pB0, pB1; float mnA, mnB, alA, alB; bf16x8 pa0, pa1, pa2, pa3; const int NT = nkeys / 64;
    SLOAD(0); SWAIT(); SWRITE(0); __syncthreads();
    qkt<NKD>(pA0, pA1, K_lds, qr, r32, hi, cbq); partialSM(pA0, pA1, m_reg, mnA, alA, C, THRS);
    SLOAD(64); SWAIT(); SWRITE(1); __syncthreads();
    for (int j = 1; j + 1 < NT; j += 2) {
        SBAR(); qkt<NKD>(pB0, pB1, K_lds + SHM_K, qr, r32, hi, cbq);
        finishSM(pA0, pA1, alA, l_reg, pa0, pa1, pa2, pa3); SBAR();
        SLOAD((j + 1) * 64); SBAR();
        PVALL(vb0); partialSM(pB0, pB1, m_reg, mnB, alB, C, THRS);
        __syncthreads(); SWAIT(); SWRITE(0);
        RESC(alB); __syncthreads();
        SBAR(); qkt<NKD>(pA0, pA1, K_lds, qr, r32, hi, cbq);
        finishSM(pB0, pB1, alB, l_reg, pa0, pa1, pa2, pa3); SBAR();
        SLOAD((j + 2) * 64); SBAR();
        PVALL(vb0 + SHM_V); partialSM(pA0, pA1, m_reg, mnA, alA, C, THRS);
        __syncthreads(); SWAIT(); SWRITE(1);
        RESC(alA); __syncthreads();
    }
    SBAR(); qkt<NKD>(pB0, pB1, K_lds + SHM_K, qr, r32, hi, cbq);
    finishSM(pA0, pA1, alA, l_reg, pa0, pa1, pa2, pa3); SBAR();
    PVALL(vb0); partialSM(pB0, pB1, m_reg, mnB, alB, C, THRS);
    __syncthreads(); RESC(alB);
    finishSM(pB0, pB1, alB, l_reg, pa0, pa1, pa2, pa3); SBAR();
    PVALL(vb0 + SHM_V);
    if (hi == 0) li_l[r32] = l_reg; asm volatile("s_waitcnt lgkmcnt(0)" ::: "memory");
    float rli[16];
#pragma unroll
    for (int r = 0; r < 16; ++r) rli[r] = __builtin_amdgcn_rcpf(li_l[crow(r, hi)]);
    if (!DIFF) {
        bf16_t* YA = WSP(bf16_t, WS_YA) + (size_t)(qrow0 + wrow) * 512 + head * 64;
#pragma unroll
        for (int r = 0; r < 16; ++r) { const int orow = crow(r, hi);
#pragma unroll
            for (int d0 = 0; d0 < NVB; ++d0) YA[(size_t)orow * 512 + d0 * 32 + r32] = f2bf(o[d0][r] * rli[r]); }
        __syncthreads();
    } else {
        const float* lf = P.diff_lam + (size_t)layer * 256;
        const float lam_init = 0.8f - 0.6f * __expf(-0.3f * (float)layer);
        const float d01 = wave_sum(lf[lane] * lf[64 + lane]), d23 = wave_sum(lf[128 + lane] * lf[192 + lane]);
        const float lam = __expf(d01) - __expf(d23) + lam_init;
        __syncthreads();
        float* EX = (float*)lds;
        float* ROWS = (float*)(lds + 65536);
        if (map == 1) {
#pragma unroll
            for (int d0 = 0; d0 < NVB; ++d0)
#pragma unroll
                for (int r = 0; r < 16; ++r) EX[(((wid & 3) * 64) + d0 * 16 + r) * 64 + lane] = o[d0][r] * rli[r];
        }
        __syncthreads();
        if (map == 0) {
            float* rw_ = ROWS + (size_t)(wid & 3) * 32 * 132;
#pragma unroll
            for (int d0 = 0; d0 < NVB; ++d0)
#pragma unroll
                for (int r = 0; r < 16; ++r) { const float v = o[d0][r] * rli[r] - lam * EX[(((wid & 3) * 64) + d0 * 16 + r) * 64 + lane]; rw_[crow(r, hi) * 132 + d0 * 32 + r32] = v; }
            asm volatile("s_waitcnt lgkmcnt(0)" ::: "memory");
            const int row = lane >> 1, hf = lane & 1; const float* rp = rw_ + row * 132 + hf * 64;
            f32x4 v[16]; float ss = 0.f;
#pragma unroll
            for (int q = 0; q < 16; ++q) { v[q] = *(const f32x4*)(rp + q * 4); ss += v[q][0] * v[q][0] + v[q][1] * v[q][1] + v[q][2] * v[q][2] + v[q][3] * v[q][3]; }
            ss += swz_xor<1>(ss);
            const float rs = rsqrtf(ss * (1.0f / 128.0f) + EPS) * (1.0f - lam_init);
            const float* ng = P.diff_norm_g + (size_t)layer * 512 + head * 128 + hf * 64;
            bf16_t* dst = WSP(bf16_t, WS_YD) + (size_t)(qrow0 + wrow + row) * 512 + head * 128 + hf * 64;
#pragma unroll
            for (int q = 0; q < 8; ++q) { const f32x4 g0 = *(const f32x4*)(ng + q * 8), g1 = *(const f32x4*)(ng + q * 8 + 4); const f32x4 a = v[2 * q], b = v[2 * q + 1];
                u32x4 w; w.x = cvt_pk_bf16(a[0] * rs * g0[0], a[1] * rs * g0[1]); w.y = cvt_pk_bf16(a[2] * rs * g0[2], a[3] * rs * g0[3]);
                w.z = cvt_pk_bf16(b[0] * rs * g1[0], b[1] * rs * g1[1]); w.w = cvt_pk_bf16(b[2] * rs * g1[2], b[3] * rs * g1[3]);
                *(u32x4*)(dst + q * 8) = w; }
        }
        __syncthreads();
    }
#undef SLOAD
#undef SWRITE
#undef SWAIT
#undef RESC
#undef PVALL
}
template <int NVB> __device__ __forceinline__ int v_stn(int k, int c) { return ((k >> 3) * NVB + (c >> 5)) * 512 + ((k & 7) * 32 + (c & 31)) * 2; }
template <int NKD> __device__ __forceinline__ void kload(bf16x8 (&kf0)[NKD], bf16x8 (&kf1)[NKD], const char* Ks, int r32, int hi, int cb0) {
#pragma unroll
    for (int d0 = 0; d0 < NKD; ++d0) { const int cb = cb0 + (d0 * 16 + hi * 8) * 2;
        kf0[d0] = *reinterpret_cast<const bf16x8*>(Ks + KSWZ(r32, cb));
        kf1[d0] = *reinterpret_cast<const bf16x8*>(Ks + KSWZ(32 + r32, cb)); }
}
template <int NKD, bool BIAS> __device__ __forceinline__ void qkmma(f32x16& p0, f32x16& p1, const bf16x8 (&kf0)[NKD], const bf16x8 (&kf1)[NKD], const bf16x8* qr, const f32x16& cref, bf16x8 qx, bf16x8 ax) {
    if constexpr (BIAS) {
        p0 = __builtin_amdgcn_mfma_f32_32x32x16_bf16(ax, qx, f32x16{}, 0, 0, 0);
        p1 = __builtin_amdgcn_mfma_f32_32x32x16_bf16(ax, qx, f32x16{}, 0, 0, 0);
    } else {
        p0 = __builtin_amdgcn_mfma_f32_32x32x16_bf16(kf0[0], qr[0], cref, 0, 0, 0);
        p1 = __builtin_amdgcn_mfma_f32_32x32x16_bf16(kf1[0], qr[0], cref, 0, 0, 0);
    }
#pragma unroll
    for (int d0 = BIAS ? 0 : 1; d0 < NKD; ++d0) {
        p0 = __builtin_amdgcn_mfma_f32_32x32x16_bf16(kf0[d0], qr[d0], p0, 0, 0, 0);
        p1 = __builtin_amdgcn_mfma_f32_32x32x16_bf16(kf1[d0], qr[d0], p1, 0, 0, 0); }
}
template <int NKD, bool BIAS> __device__ __forceinline__ void qkt2(f32x16& p0, f32x16& p1, const char* Ks, const bf16x8* qr, const f32x16& cref, bf16x8 qx, bf16x8 ax, int r32, int hi, int cb0) {
    bf16x8 kf0[NKD], kf1[NKD]; kload<NKD>(kf0, kf1, Ks, r32, hi, cb0); qkmma<NKD, BIAS>(p0, p1, kf0, kf1, qr, cref, qx, ax);
}
template <int NVB, int D0> __device__ __forceinline__ void pv2_one(f32x16& od, int vb, bf16x8 b0, bf16x8 b1, bf16x8 b2, bf16x8 b3) {
    const s16x4 l0 = tr_read<v_rd_off<NVB>(D0, 0, 0)>(vb), h0 = tr_read<v_rd_off<NVB>(D0, 0, 1)>(vb), l1 = tr_read<v_rd_off<NVB>(D0, 1, 0)>(vb), h1 = tr_read<v_rd_off<NVB>(D0, 1, 1)>(vb);
    const s16x4 l2 = tr_read<v_rd_off<NVB>(D0, 2, 0)>(vb), h2 = tr_read<v_rd_off<NVB>(D0, 2, 1)>(vb), l3 = tr_read<v_rd_off<NVB>(D0, 3, 0)>(vb), h3 = tr_read<v_rd_off<NVB>(D0, 3, 1)>(vb);
    asm volatile("s_waitcnt lgkmcnt(0)" ::: "memory"); SBAR();
    od = __builtin_amdgcn_mfma_f32_32x32x16_bf16(PKF(l0, h0), b0, od, 0, 0, 0);
    od = __builtin_amdgcn_mfma_f32_32x32x16_bf16(PKF(l1, h1), b1, od, 0, 0, 0);
    od = __builtin_amdgcn_mfma_f32_32x32x16_bf16(PKF(l2, h2), b2, od, 0, 0, 0);
    od = __builtin_amdgcn_mfma_f32_32x32x16_bf16(PKF(l3, h3), b3, od, 0, 0, 0);
}
template <int NVB, int D0> __device__ __forceinline__ void pv2_pair(f32x16& oa, f32x16& ob, int vb, bf16x8 b0, bf16x8 b1, bf16x8 b2, bf16x8 b3) {
    const s16x4 l0 = tr_read<v_rd_off<NVB>(D0, 0, 0)>(vb), h0 = tr_read<v_rd_off<NVB>(D0, 0, 1)>(vb), l1 = tr_read<v_rd_off<NVB>(D0, 1, 0)>(vb), h1 = tr_read<v_rd_off<NVB>(D0, 1, 1)>(vb);
    const s16x4 l2 = tr_read<v_rd_off<NVB>(D0, 2, 0)>(vb), h2 = tr_read<v_rd_off<NVB>(D0, 2, 1)>(vb), l3 = tr_read<v_rd_off<NVB>(D0, 3, 0)>(vb), h3 = tr_read<v_rd_off<NVB>(D0, 3, 1)>(vb);
    const s16x4 m0 = tr_read<v_rd_off<NVB>(D0 + 1, 0, 0)>(vb), n0 = tr_read<v_rd_off<NVB>(D0 + 1, 0, 1)>(vb), m1 = tr_read<v_rd_off<NVB>(D0 + 1, 1, 0)>(vb), n1 = tr_read<v_rd_off<NVB>(D0 + 1, 1, 1)>(vb);
    const s16x4 m2 = tr_read<v_rd_off<NVB>(D0 + 1, 2, 0)>(vb), n2 = tr_read<v_rd_off<NVB>(D0 + 1, 2, 1)>(vb), m3 = tr_read<v_rd_off<NVB>(D0 + 1, 3, 0)>(vb), n3 = tr_read<v_rd_off<NVB>(D0 + 1, 3, 1)>(vb);
    asm volatile("s_waitcnt lgkmcnt(0)" ::: "memory"); SBAR();
    oa = __builtin_amdgcn_mfma_f32_32x32x16_bf16(PKF(l0, h0), b0, oa, 0, 0, 0); ob = __builtin_amdgcn_mfma_f32_32x32x16_bf16(PKF(m0, n0), b0, ob, 0, 0, 0);
    oa = __builtin_amdgcn_mfma_f32_32x32x16_bf16(PKF(l1, h1), b1, oa, 0, 0, 0); ob = __builtin_amdgcn_mfma_f32_32x32x16_bf16(PKF(m1, n1), b1, ob, 0, 0, 0);
    oa = __builtin_amdgcn_mfma_f32_32x32x16_bf16(PKF(l2, h2), b2, oa, 0, 0, 0); ob = __builtin_amdgcn_mfma_f32_32x32x16_bf16(PKF(m2, n2), b2, ob, 0, 0, 0);
    oa = __builtin_amdgcn_mfma_f32_32x32x16_bf16(PKF(l3, h3), b3, oa, 0, 0, 0); ob = __builtin_amdgcn_mfma_f32_32x32x16_bf16(PKF(m3, n3), b3, ob, 0, 0, 0);
}
__device__ __forceinline__ float swap_max(float v) { auto rr = __builtin_amdgcn_permlane32_swap(__float_as_uint(v), __float_as_uint(v), false, false); return fmaxf(__uint_as_float(rr[0]), __uint_as_float(rr[1])); }
__device__ __forceinline__ float swap_add(float v) { auto rr = __builtin_amdgcn_permlane32_swap(__float_as_uint(v), __float_as_uint(v), false, false); return __uint_as_float(rr[0]) + __uint_as_float(rr[1]); }
__device__ __forceinline__ bf16x8 pack8(const f32x16& p, int base) {
    u32x4 w; w.x = cvt_pk_bf16(p[base + 0], p[base + 1]); w.y = cvt_pk_bf16(p[base + 2], p[base + 3]); w.z = cvt_pk_bf16(p[base + 4], p[base + 5]); w.w = cvt_pk_bf16(p[base + 6], p[base + 7]);
    return *reinterpret_cast<bf16x8*>(&w);
}

template <int NVB, class F> __device__ __forceinline__ void pv2_split(f32x16& oa, f32x16& ob, int vb, bf16x8 b0, bf16x8 b1, f32x16& p1, float& lb, F&& hook) {
    s16x4 l0 = tr_read<v_rd_off<NVB>(0, 0, 0)>(vb), h0 = tr_read<v_rd_off<NVB>(0, 0, 1)>(vb), m0 = tr_read<v_rd_off<NVB>(1, 0, 0)>(vb), n0 = tr_read<v_rd_off<NVB>(1, 0, 1)>(vb);
    s16x4 l1 = tr_read<v_rd_off<NVB>(0, 1, 0)>(vb), h1 = tr_read<v_rd_off<NVB>(0, 1, 1)>(vb), m1 = tr_read<v_rd_off<NVB>(1, 1, 0)>(vb), n1 = tr_read<v_rd_off<NVB>(1, 1, 1)>(vb);
    s16x4 l2 = tr_read<v_rd_off<NVB>(0, 2, 0)>(vb), h2 = tr_read<v_rd_off<NVB>(0, 2, 1)>(vb), m2 = tr_read<v_rd_off<NVB>(1, 2, 0)>(vb), n2 = tr_read<v_rd_off<NVB>(1, 2, 1)>(vb);
    s16x4 l3 = tr_read<v_rd_off<NVB>(0, 3, 0)>(vb), h3 = tr_read<v_rd_off<NVB>(0, 3, 1)>(vb), m3 = tr_read<v_rd_off<NVB>(1, 3, 0)>(vb), n3 = tr_read<v_rd_off<NVB>(1, 3, 1)>(vb);
    hook();
    asm volatile("s_waitcnt lgkmcnt(8)" : "+v"(l0), "+v"(h0), "+v"(m0), "+v"(n0), "+v"(l1), "+v"(h1), "+v"(m1), "+v"(n1) :: "memory"); SBAR();
    oa = __builtin_amdgcn_mfma_f32_32x32x16_bf16(PKF(l0, h0), b0, oa, 0, 0, 0); ob = __builtin_amdgcn_mfma_f32_32x32x16_bf16(PKF(m0, n0), b0, ob, 0, 0, 0);
    oa = __builtin_amdgcn_mfma_f32_32x32x16_bf16(PKF(l1, h1), b1, oa, 0, 0, 0); ob = __builtin_amdgcn_mfma_f32_32x32x16_bf16(PKF(m1, n1), b1, ob, 0, 0, 0);
#pragma unroll
    for (int r = 0; r < 16; ++r) p1[r] = __builtin_amdgcn_exp2f(p1[r]);
#pragma unroll
    for (int r = 0; r < 16; ++r) lb += p1[r];
    const bf16x8 b2 = pack8(p1, 0), b3 = pack8(p1, 8);
    asm volatile("s_waitcnt lgkmcnt(0)" : "+v"(l2), "+v"(h2), "+v"(m2), "+v"(n2), "+v"(l3), "+v"(h3), "+v"(m3), "+v"(n3) :: "memory");
    oa = __builtin_amdgcn_mfma_f32_32x32x16_bf16(PKF(l2, h2), b2, oa, 0, 0, 0); ob = __builtin_amdgcn_mfma_f32_32x32x16_bf16(PKF(m2, n2), b2, ob, 0, 0, 0);
    oa = __builtin_amdgcn_mfma_f32_32x32x16_bf16(PKF(l3, h3), b3, oa, 0, 0, 0); ob = __builtin_amdgcn_mfma_f32_32x32x16_bf16(PKF(m3, n3), b3, ob, 0, 0, 0);
}
template <int NVB, int KS> __device__ __forceinline__ void pv4_read(s16x4 (&v)[8], int vb) {
    v[0] = tr_read<v_rd_off<NVB>(0, KS, 0)>(vb); v[1] = tr_read<v_rd_off<NVB>(0, KS, 1)>(vb); v[2] = tr_read<v_rd_off<NVB>(1, KS, 0)>(vb); v[3] = tr_read<v_rd_off<NVB>(1, KS, 1)>(vb);
    v[4] = tr_read<v_rd_off<NVB>(2, KS, 0)>(vb); v[5] = tr_read<v_rd_off<NVB>(2, KS, 1)>(vb); v[6] = tr_read<v_rd_off<NVB>(3, KS, 0)>(vb); v[7] = tr_read<v_rd_off<NVB>(3, KS, 1)>(vb);
}
template <int NVB> __device__ __forceinline__ void pv4_mma(f32x16 (&o)[NVB], const s16x4 (&v)[8], bf16x8 b) {
    o[0] = __builtin_amdgcn_mfma_f32_32x32x16_bf16(PKF(v[0], v[1]), b, o[0], 0, 0, 0); o[1] = __builtin_amdgcn_mfma_f32_32x32x16_bf16(PKF(v[2], v[3]), b, o[1], 0, 0, 0);
    o[2] = __builtin_amdgcn_mfma_f32_32x32x16_bf16(PKF(v[4], v[5]), b, o[2], 0, 0, 0); o[3] = __builtin_amdgcn_mfma_f32_32x32x16_bf16(PKF(v[6], v[7]), b, o[3], 0, 0, 0);
}
#define PV4_WAIT(n, v) asm volatile("s_waitcnt lgkmcnt(" #n ")" : "+v"(v[0]), "+v"(v[1]), "+v"(v[2]), "+v"(v[3]), "+v"(v[4]), "+v"(v[5]), "+v"(v[6]), "+v"(v[7]) :: "memory")
template <int NVB, class F> __device__ __forceinline__ void pv4_split(f32x16 (&o)[NVB], int vb, bf16x8 b0, bf16x8 b1, f32x16& p1, float& lb, F&& hook) {
    s16x4 va[8], vb8[8];
    pv4_read<NVB, 0>(va, vb); pv4_read<NVB, 1>(vb8, vb);
    hook();
    PV4_WAIT(8, va); SBAR(); pv4_mma<NVB>(o, va, b0);
    pv4_read<NVB, 2>(va, vb);
    PV4_WAIT(8, vb8); SBAR(); pv4_mma<NVB>(o, vb8, b1);
#pragma unroll
    for (int r = 0; r < 16; ++r) p1[r] = __builtin_amdgcn_exp2f(p1[r]);
#pragma unroll
    for (int r = 0; r < 16; ++r) lb += p1[r];
    const bf16x8 b2 = pack8(p1, 0), b3 = pack8(p1, 8);
    pv4_read<NVB, 3>(vb8, vb);
    PV4_WAIT(8, va); SBAR(); pv4_mma<NVB>(o, va, b2);
    PV4_WAIT(0, vb8); SBAR(); pv4_mma<NVB>(o, vb8, b3);
}
#undef PV4_WAIT
template <bool DIFF>
__device__ __forceinline__ void attn_unit3(const Params& P, int layer, char* lds, int head, int qrow0, int key0, int nkeys) {
    constexpr int NKD = DIFF ? 4 : 6, NVB = DIFF ? 4 : 2;
    constexpr int SHM_K = 64 * 256, SHM_V = 64 * NVB * 64, SLOT = SHM_K + SHM_V;
    constexpr float SCALE = DIFF ? 0.125f : 0.10206207261596577f;
    constexpr float C = SCALE * 1.4426950408889634f, THR2 = 8.0f * 1.4426950408889634f;
    const int tid = tidx(), wid = tid >> 6, lane = tid & 63, r32 = lane & 31, hi = lane >> 5;
    const int map = DIFF ? (wid >> 2) : 0, wrow = DIFF ? (wid & 3) * 32 : wid * 32;
    const int qrow = qrow0 + wrow + r32;
    const bf16_t* Y = WSP(const bf16_t, WS_Y); const bf16_t* KD = WSP(const bf16_t, WS_KD); const bf16_t* KVR = WSP(const bf16_t, WS_KVRAW); const bf16_t* KPE = WSP(const bf16_t, WS_KPE);
    float lfa = 0.f, lfb = 0.f, lfc = 0.f, lfd = 0.f;
    if constexpr (DIFF) { const float* lf = P.diff_lam + (size_t)layer * 256; lfa = lf[lane]; lfb = lf[64 + lane]; lfc = lf[128 + lane]; lfd = lf[192 + lane]; }
    bf16x8 qr[NKD];
    { const bf16_t* qsrc = DIFF ? (Y + (size_t)qrow * NINP + C_DQ + (2 * head + map) * 64 + hi * 8) : (WSP(const bf16_t, WS_QRAW) + (size_t)qrow * 768 + head * 96 + hi * 8);
#pragma unroll
      for (int d0 = 0; d0 < NKD; ++d0) qr[d0] = *reinterpret_cast<const bf16x8*>(qsrc + d0 * 16);
    }
    constexpr bool BIAS = DIFF;
    f32x16 cref = f32x16{};
    bf16x8 qx; { const u32x4 z = {0u, 0u, 0u, 0u}; qx = *reinterpret_cast<const bf16x8*>(&z); }
    bf16x8 ax; { const u32x4 w = {hi == 0 ? 0x3F803F80u : 0u, 0u, 0u, 0u}; ax = *reinterpret_cast<const bf16x8*>(&w); }
    constexpr int NCW = DIFF ? 4 : 3;
    const char* dsrc[NCW]; unsigned dstr[NCW]; int doff[NCW];
#pragma unroll
    for (int i = 0; i < NCW; ++i) { const int c = wid * NCW + i;
        if (c < 16) { const int row = 4 * c + (lane >> 4), gpos = lane & 15, g = gpos ^ ((row & 7) | (((row >> 4) & 1) << 3));
            if (DIFF) { dsrc[i] = (const char*)(KD + ((size_t)head * LT + (size_t)(key0 + row)) * 256 + g * 8); dstr[i] = 256 * 2; }
            else if (g >= 8 && g < 12) { dsrc[i] = (const char*)(KPE + (size_t)(key0 + row) * 32 + (g - 8) * 8); dstr[i] = 32 * 2; }
            else { dsrc[i] = (const char*)(KVR + ((size_t)head * LT + (size_t)(key0 + row)) * 128 + (g & 7) * 8); dstr[i] = 128 * 2; }
            doff[i] = c * 1024;
        } else { const int cv = c - 16, stl = 2 * cv + (lane >> 5), key = 8 * (stl / NVB) + ((lane & 31) >> 2), col = 32 * (stl % NVB) + 8 * (lane & 3);
            if (DIFF) { dsrc[i] = (const char*)(KD + ((size_t)head * LT + (size_t)(key0 + key)) * 256 + 128 + col); dstr[i] = 256 * 2; }
            else { dsrc[i] = (const char*)(KVR + ((size_t)head * LT + (size_t)(key0 + key)) * 128 + 64 + col); dstr[i] = 128 * 2; }
            doff[i] = SHM_K + cv * 1024; } }
    LAS unsigned char* ldsl = (LAS unsigned char*)lds;
#pragma unroll
    for (int i = 0; i < NCW; ++i) { doff[i] = __builtin_amdgcn_readfirstlane(doff[i]); dstr[i] *= 64u; }
#define DMA(tile, so) do { _Pragma("unroll") for (int i_ = 0; i_ < NCW; ++i_) { \
        __builtin_amdgcn_global_load_lds((const unsigned*)dsrc[i_], (LAS unsigned*)(ldsl + (so) + doff[i_]), 16, 0, 0); dsrc[i_] += dstr[i_]; } } while (0)
#define WGBAR() do { asm volatile("s_waitcnt lgkmcnt(0)" ::: "memory"); __builtin_amdgcn_s_barrier(); asm volatile("" ::: "memory"); } while (0)
#define REBUILD_QX() do { const float nm_ = -mref; if constexpr (BIAS) { const unsigned hb_ = cvt_pk_bf16(nm_, 0.f) & 0xffffu; const float hf_ = __uint_as_float(hb_ << 16); \
        const unsigned lb_ = cvt_pk_bf16(nm_ - hf_, 0.f) & 0xffffu; const u32x4 w_ = {hi == 0 ? (hb_ | (lb_ << 16)) : 0u, 0u, 0u, 0u}; qx = *reinterpret_cast<const bf16x8*>(&w_); } \
        else { _Pragma("unroll") for (int r = 0; r < 16; ++r) cref[r] = nm_; asm volatile("" : "+v"(cref)); } } while (0)
#define ROWMAX(p0, p1, out) do { float t_ = p0[0]; _Pragma("unroll") for (int r = 1; r < 16; ++r) t_ = fmaxf(t_, p0[r]); _Pragma("unroll") for (int r = 0; r < 16; ++r) t_ = fmaxf(t_, p1[r]); out = swap_max(t_); } while (0)
#define EXPSUM(p0, p1) do { \
        _Pragma("unroll") for (int r = 0; r < 16; ++r) p0[r] = __builtin_amdgcn_exp2f(p0[r]); \
        _Pragma("unroll") for (int r = 0; r < 16; ++r) la += p0[r]; \
        bf0 = pack8(p0, 0); bf1 = pack8(p0, 8); } while (0)
#define ADJUST(p0, p1) do { const float ts_ = la + lb; \
        if (__builtin_expect(__any(ts_ > 1.0995116e12f), 0)) { const float tr_ = swap_max(ts_); \
            const float d_ = tr_ > 1.0995116e12f ? (float)((int)((__float_as_uint(tr_) >> 23) & 0xffu) - 127) : 0.f; const float al_ = __builtin_amdgcn_exp2f(-d_); \
            _Pragma("unroll") for (int r = 0; r < 16; ++r) { p0[r] -= d_; p1[r] -= d_; } \
            _Pragma("unroll") for (int d = 0; d < NVB; ++d) _Pragma("unroll") for (int r = 0; r < 16; ++r) o[d][r] *= al_; \
            la *= al_; lb *= al_; mref += d_; REBUILD_QX(); } } while (0)
#define PVALL(so, p1_, HK) do { const int vb_ = vbase + (so); \
        if constexpr (NVB == 2) { pv2_split<NVB>(o[0], o[1], vb_, bf0, bf1, p1_, lb, HK); } \
        else { pv4_split<NVB>(o, vb_, bf0, bf1, p1_, lb, HK); } } while (0)
#define SLOTOF(k) ((((k) >= NS) ? (k) - NS : (k)) * SLOT)
#define STEPF(pc0, pc1, pn0, pn1) do { \
        const int s_cur = SLOTOF(cur), s_nxt = SLOTOF(cur + 1), s_req = SLOTOF(cur + PD); \
        kload<NKD>(kf0, kf1, lds + s_nxt, r32, hi, cbq); SBAR(); \
        ADJUST(pc0, pc1); \
        SBAR(); qkmma<NKD, BIAS>(pn0, pn1, kf0, kf1, qr, cref, qx, ax); \
        EXPSUM(pc0, pc1); SBAR(); \
        PVALL(s_cur, pc1, [&]() { DMA(j + PD, s_req); }); \
        if constexpr (DIFF) asm volatile("s_waitcnt vmcnt(4)" ::: "memory"); else asm volatile("s_waitcnt vmcnt(3)" ::: "memory"); WGBAR(); \
        cur = (cur + 1 >= NS) ? 0 : cur + 1; ++j; } while (0)
    const int vbase = lds_addr(lds) + SHM_K + v_rd_base(lane);
    const int cbq = DIFF ? map * 128 : 0;
    float mref = 0.f, la = 0.f, lb = 0.f; f32x16 o[NVB];
#pragma unroll
    for (int d = 0; d < NVB; ++d) o[d] = f32x16{};
    f32x16 pA0, pA1, pB0, pB1; bf16x8 bf0, bf1, bf2, bf3; bf16x8 kf0[NKD], kf1[NKD]; const int NT = nkeys / 64;
    constexpr int PD = 3, NS = 4;
    int cur = 0, j = 0;
#pragma unroll
    for (int t = 0; t < PD; ++t) DMA(t, t * SLOT);
    {
      const bool lat = qrow < L; const float prow = (float)(qrow >> 6), pcol = (float)(qrow & 63);
      constexpr int R0 = DIFF ? 0 : 4, RN = DIFF ? 2 : 1, RP = DIFF ? 2 : 1;
#pragma unroll
      for (int d0 = 0; d0 < NKD; ++d0) {
          const bool isx1 = (d0 >= R0 && d0 < R0 + RN), isx2 = (d0 >= R0 + RP && d0 < R0 + RP + RN);
          if (isx2) continue;
          if (isx1) {
#pragma unroll
              for (int i = 0; i < 8; ++i) { float x1 = bf2f((bf16_t)qr[d0][i]), x2 = bf2f((bf16_t)qr[d0 + RP][i]); float o1 = x1, o2 = x2;
                  if (lat) { float ang;
                      if (DIFF) { const int t = hi * 8 + i; ang = ((d0 - R0) == 0 ? prow : pcol) * exp2f(-(float)t * (13.287712379549449f / 16.0f)); }
                      else { ang = (hi == 0 ? prow : pcol) * exp2f(-(float)i * (13.287712379549449f / 8.0f)); }
                      float s, c; sincos_rev(ang, s, c); o1 = x1 * c - x2 * s; o2 = x1 * s + x2 * c; }
                  qr[d0][i] = (short)f2bf(o1 * C); qr[d0 + RP][i] = (short)f2bf(o2 * C); }
          } else {
#pragma unroll
              for (int i = 0; i < 8; ++i) qr[d0][i] = (short)f2bf(bf2f((bf16_t)qr[d0][i]) * C);
          } }
    }
    if constexpr (DIFF) asm volatile("s_waitcnt vmcnt(4)" ::: "memory"); else asm volatile("s_waitcnt vmcnt(3)" ::: "memory");
    WGBAR();
    mref = 0.f; REBUILD_QX();
    qkt2<NKD, BIAS>(pA0, pA1, lds, qr, cref, qx, ax, r32, hi, cbq);
    { float rm0; ROWMAX(pA0, pA1, rm0); mref = rm0;
#pragma unroll
      for (int r = 0; r < 16; ++r) { pA0[r] -= rm0; pA1[r] -= rm0; }
      REBUILD_QX(); }
    while (j < NT) { STEPF(pA0, pA1, pB0, pB1); STEPF(pB0, pB1, pA0, pA1); }
    asm volatile("s_waitcnt vmcnt(0)" ::: "memory"); WGBAR();
    const float inv = __builtin_amdgcn_rcpf(swap_add(la + lb));
    if (!DIFF) {
        bf16_t* dst = WSP(bf16_t, WS_YA) + (size_t)qrow * 512 + head * 64 + 4 * hi;
#pragma unroll
        for (int d0 = 0; d0 < NVB; ++d0)
#pragma unroll
            for (int g = 0; g < 4; ++g) { u32x2 w; w.x = cvt_pk_bf16(o[d0][4 * g] * inv, o[d0][4 * g + 1] * inv); w.y = cvt_pk_bf16(o[d0][4 * g + 2] * inv, o[d0][4 * g + 3] * inv);
                *(u32x2*)(dst + d0 * 32 + g * 8) = w; }
        asm volatile("s_waitcnt vmcnt(0)" ::: "memory"); __syncthreads();
    } else {
        const float lam_init = 0.8f - 0.6f * __expf(-0.3f * (float)layer);
        const float d01 = wave_sum(lfa * lfb), d23 = wave_sum(lfc * lfd);
        const float lam = __expf(d01) - __expf(d23) + lam_init;
        float* EX = (float*)lds;
        f32x4 gg[NVB][4];
        if (map == 0) { const float* ng_ = P.diff_norm_g + (size_t)layer * 512 + head * 128 + 4 * hi;
#pragma unroll
            for (int d0 = 0; d0 < NVB; ++d0)
#pragma unroll
                for (int g = 0; g < 4; ++g) gg[d0][g] = *(const f32x4*)(ng_ + d0 * 32 + g * 8); }
        if (map == 1) {
#pragma unroll
            for (int d0 = 0; d0 < NVB; ++d0)
#pragma unroll
                for (int r = 0; r < 16; ++r) EX[(((wid & 3) * 64) + d0 * 16 + r) * 64 + lane] = o[d0][r] * inv;
        }
        __syncthreads();
        if (map == 0) {
            float ss = 0.f;
#pragma unroll
            for (int d0 = 0; d0 < NVB; ++d0)
#pragma unroll
                for (int r = 0; r < 16; ++r) { const float v = o[d0][r] * inv - lam * EX[(((wid & 3) * 64) + d0 * 16 + r) * 64 + lane]; o[d0][r] = v; ss += v * v; }
            ss = swap_add(ss);
            const float rs = rsqrtf(ss * (1.0f / 128.0f) + EPS) * (1.0f - lam_init);
            bf16_t* dst = WSP(bf16_t, WS_YD) + (size_t)qrow * 512 + head * 128 + 4 * hi;
#pragma unroll
            for (int d0 = 0; d0 < NVB; ++d0)
#pragma unroll
                for (int g = 0; g < 4; ++g) { const f32x4 gv = gg[d0][g];
                    u32x2 w; w.x = cvt_pk_bf16(o[d0][4 * g] * rs * gv[0], o[d0][4 * g + 1] * rs * gv[1]); w.y = cvt_pk_bf16(o[d0][4 * g + 2] * rs * gv[2], o[d0][4 * g + 3] * rs * gv[3]);
                    *(u32x2*)(dst + d0 * 32 + g * 8) = w; }
        }
        __syncthreads();
    }
#undef DMA
#undef WGBAR
#undef SLOTOF
#undef REBUILD_QX
#undef ROWMAX
#undef ADJUST
#undef EXPSUM
#undef PVALL
#undef STEPF
}
__device__ __forceinline__ float scan_sum(float v, bool fwd, int lane) {
#pragma unroll
    for (int off = 1; off < 64; off <<= 1) { const int src = fwd ? lane - off : lane + off; const float t = lane_read(v, src & 63); if (src >= 0 && src < 64) v += t; }
    return v;
}
__device__ __forceinline__ float scan_max(float v, bool fwd, int lane) {
#pragma unroll
    for (int off = 1; off < 64; off <<= 1) { const int src = fwd ? lane - off : lane + off; const float t = lane_read(v, src & 63); if (src >= 0 && src < 64) v = fmaxf(v, t); }
    return v;
}
#define DPPF(old_, src_, ctrl_, rmask_) __int_as_float(__builtin_amdgcn_update_dpp(__float_as_int(old_), __float_as_int(src_), ctrl_, rmask_, 0xf, false))
__device__ __forceinline__ void gate_scans(float lf, float ig, bool fwd, int lane, float& bc, float& a, float& pm) {
    const int rl = fwd ? lane : 63 - lane;
    const float l2 = lane_read(lf, rl), i2 = lane_read(ig, rl);
    float s = l2;
    s += DPPF(0.f, s, 0x111, 0xf); s += DPPF(0.f, s, 0x112, 0xf); s += DPPF(0.f, s, 0x114, 0xf); s += DPPF(0.f, s, 0x118, 0xf);
    s += DPPF(0.f, s, 0x142, 0xa); s += DPPF(0.f, s, 0x143, 0xc);
    float m = i2 - s;
    m = fmaxf(m, DPPF(-3.0e38f, m, 0x111, 0xf)); m = fmaxf(m, DPPF(-3.0e38f, m, 0x112, 0xf)); m = fmaxf(m, DPPF(-3.0e38f, m, 0x114, 0xf)); m = fmaxf(m, DPPF(-3.0e38f, m, 0x118, 0xf));
    m = fmaxf(m, DPPF(-3.0e38f, m, 0x142, 0xa)); m = fmaxf(m, DPPF(-3.0e38f, m, 0x143, 0xc));
    bc = lane_read(s, rl); pm = lane_read(m, rl); a = ig - bc;
}
__device__ __forceinline__ float gate_val(const bf16_t* yrow, const float* gb, int idx) {
    float g = bf2f(yrow[C_MG + idx]) + gb[idx];
    { const float e2 = __builtin_amdgcn_exp2f(g * (2.0f / 15.0f * 1.4426950408889634f)); g = 15.0f * (1.0f - 2.0f * __builtin_amdgcn_rcpf(e2 + 1.0f)); }
    if ((idx >> 2) & 1) g = fminf(g, 0.f) - __logf(1.0f + __expf(-fabsf(g)));
    return g;
}
__device__ __forceinline__ void mlstm_local_unit(const Params& P, int layer, char* lds, int pc, int h) {
    const int tid = tidx(), wid = tid >> 6, lane = tid & 63, r32 = lane & 31, hi = lane >> 5;
    char* KW = lds; char* VI = lds + 32768; float* wgt = (float*)(lds + 49152);
    const bf16_t* Y = WSP(const bf16_t, WS_Y) + (size_t)pc * 64 * NINP;
    if (wid < 2) { const int dir = wid; const bool fwd = dir == 0; const float* gb = P.m_gate_b + (size_t)layer * 16;
        const float ig = gate_val(Y + (size_t)lane * NINP, gb, dir * 8 + h), lf = gate_val(Y + (size_t)lane * NINP, gb, dir * 8 + 4 + h);
        const float bc = scan_sum(lf, fwd, lane); const float a = ig - bc; const float amax = wave_max(a);
        wgt[dir * 64 + lane] = __expf(a - amax);
        const float bl = __int_as_float(fwd ? __builtin_amdgcn_readlane(__float_as_int(bc), 63) : __builtin_amdgcn_readlane(__float_as_int(bc), 0));
        if (lane == 0) { float* sc = WSP(float, WS_SCAL) + ((size_t)(dir * 4 + h) * NCH + pc) * 2; sc[0] = bl; sc[1] = bl + amax; } }
    u32x4 kq[2], vq[2];
    { const int sr = tid >> 4, sc = (tid & 15) * 8;
#pragma unroll
      for (int q = 0; q < 2; ++q) { const int rr = sr + 32 * q; kq[q] = *(const u32x4*)(Y + (size_t)rr * NINP + C_MK + h * 128 + sc); vq[q] = *(const u32x4*)(Y + (size_t)rr * NINP + C_MV + h * 128 + sc); } }
    __syncthreads();
    { const int sr = tid >> 4, sc = (tid & 15) * 8;
#pragma unroll
      for (int q = 0; q < 2; ++q) { const int rr = sr + 32 * q; const u32x4 kv = kq[q], vv = vq[q];
          const float w0 = wgt[rr], w1 = wgt[64 + rr];
          const float kf[8] = {bflo(kv.x), bfhi(kv.x), bflo(kv.y), bfhi(kv.y), bflo(kv.z), bfhi(kv.z), bflo(kv.w), bfhi(kv.w)};
          u32x4 a, b; a.x = cvt_pk_bf16(kf[0] * w0, kf[1] * w0); a.y = cvt_pk_bf16(kf[2] * w0, kf[3] * w0); a.z = cvt_pk_bf16(kf[4] * w0, kf[5] * w0); a.w = cvt_pk_bf16(kf[6] * w0, kf[7] * w0);
          b.x = cvt_pk_bf16(kf[0] * w1, kf[1] * w1); b.y = cvt_pk_bf16(kf[2] * w1, kf[3] * w1); b.z = cvt_pk_bf16(kf[4] * w1, kf[5] * w1); b.w = cvt_pk_bf16(kf[6] * w1, kf[7] * w1);
          const int off = v_st<4>(rr, sc);
          *(u32x4*)(KW + off) = a; *(u32x4*)(KW + 16384 + off) = b; *(u32x4*)(VI + off) = vv; } }
    __syncthreads();
    const int dir = wid >> 2, rb = wid & 3, chain = dir * 4 + h;
    { const int ab = lds_addr(KW + dir * 16384) + v_rd_base(lane) + rb * 512, bb = lds_addr(VI) + v_rd_base(lane);
      f32x16 acc[4];
#pragma unroll
      for (int d = 0; d < 4; ++d) acc[d] = f32x16{};
#define M1STEP(KS) do { const s16x4 al_ = tr_read<v_rd_off<4>(0, KS, 0)>(ab), ah_ = tr_read<v_rd_off<4>(0, KS, 1)>(ab); \
        const s16x4 b0l = tr_read<v_rd_off<4>(0, KS, 0)>(bb), b0h = tr_read<v_rd_off<4>(0, KS, 1)>(bb), b1l = tr_read<v_rd_off<4>(1, KS, 0)>(bb), b1h = tr_read<v_rd_off<4>(1, KS, 1)>(bb); \
        const s16x4 b2l = tr_read<v_rd_off<4>(2, KS, 0)>(bb), b2h = tr_read<v_rd_off<4>(2, KS, 1)>(bb), b3l = tr_read<v_rd_off<4>(3, KS, 0)>(bb), b3h = tr_read<v_rd_off<4>(3, KS, 1)>(bb); \
        asm volatile("s_waitcnt lgkmcnt(0)" ::: "memory"); SBAR(); const bf16x8 af = PKF(al_, ah_); \
        acc[0] = __builtin_amdgcn_mfma_f32_32x32x16_bf16(af, PKF(b0l, b0h), acc[0], 0, 0, 0); acc[1] = __builtin_amdgcn_mfma_f32_32x32x16_bf16(af, PKF(b1l, b1h), acc[1], 0, 0, 0); \
        acc[2] = __builtin_amdgcn_mfma_f32_32x32x16_bf16(af, PKF(b2l, b2h), acc[2], 0, 0, 0); acc[3] = __builtin_amdgcn_mfma_f32_32x32x16_bf16(af, PKF(b3l, b3h), acc[3], 0, 0, 0); } while (0)
      M1STEP(0); M1STEP(1); M1STEP(2); M1STEP(3);
#undef M1STEP
      bf16_t* Cl = WSP(bf16_t, WS_CLOC) + ((size_t)chain * NCH + pc) * 16384;
#pragma unroll
      for (int d0 = 0; d0 < 4; ++d0)
#pragma unroll
          for (int r = 0; r < 16; ++r) Cl[(size_t)(rb * 32 + crow(r, hi)) * 128 + d0 * 32 + r32] = f2bf(acc[d0][r]); }
    if (tid < 256) { const int d2 = tid >> 7, d = tid & 127; float s = 0.f; const char* kw = KW + d2 * 16384;
        for (int t = 0; t < 64; ++t) s += bf2f(*(const bf16_t*)(kw + v_st<4>(t, d)));
        WSP(float, WS_NLOC)[((size_t)(d2 * 4 + h) * NCH + pc) * 128 + d] = s; }
    __syncthreads();
}
__device__ __forceinline__ void phase_mlstm_local(const Params& P, int layer, char* lds) {
    for (int u = blockIdx.x; u < NCH * 4; u += gridDim.x) mlstm_local_unit(P, layer, lds, u >> 2, u & 3);
}
__device__ __forceinline__ int chain_pc(int dir, int ci) { return dir ? (NCH - 1 - ci) : (ci < 4 ? 256 + ci : ci - 4); }
__device__ __forceinline__ void phase_mlstm_scan(const Params& P, char* shm) {
    const int tid = tidx(), lane = tid & 63, b = blockIdx.x;
    f32x2* coef = (f32x2*)shm;
    for (int gb = b; gb < 256; gb += gridDim.x) {
        const int chainC = gb >> 5;
        { const int ws_ = tid >> 6;
          if (ws_ == 0 || (ws_ < 3 && gb < 4)) { const int chain = ws_ == 0 ? chainC : 2 * gb + (ws_ - 1); const int dir = chain >> 2;
            const float* sc = WSP(const float, WS_SCAL) + (size_t)chain * NCH * 2; float* mst = WSP(float, WS_MST) + (size_t)chain * NCH;
            float a5[5], b5[5]; float A = 0.f, B = -3.0e38f;
#pragma unroll
            for (int q = 0; q < 5; ++q) { const int ci = lane * 5 + q; const bool ok = ci < NCH; const int pc = chain_pc(dir, ok ? ci : 0);
                a5[q] = ok ? sc[pc * 2] : 0.f; b5[q] = ok ? sc[pc * 2 + 1] : -3.0e38f;
                B = fmaxf(B + a5[q], b5[q]); A += a5[q]; }
#pragma unroll
            for (int off = 1; off < 64; off <<= 1) { const int src = lane - off; const float Ap = lane_read(A, src & 63), Bp = lane_read(B, src & 63);
                if (src >= 0) { B = fmaxf(Bp + A, B); A = Ap + A; } }
            float Ae = lane_read(A, (lane - 1) & 63), Be = lane_read(B, (lane - 1) & 63); if (lane == 0) { Ae = 0.f; Be = -3.0e38f; }
            float m = fmaxf(0.f + Ae, Be);
#pragma unroll
            for (int q = 0; q < 5; ++q) { const int ci = lane * 5 + q;
                if (ci < NCH) { const int pc = chain_pc(dir, ci); if (ws_ == 0 && (gb & 31) == 0) mst[pc] = m;
                    const float mn = fmaxf(a5[q] + m, b5[q]); coef[ws_ * NCH + ci] = (f32x2){__expf(a5[q] + m - mn), __expf(b5[q] - mn)}; m = mn; } } } }
        __syncthreads();
        if (tid < 256) {
            const int gtid = gb * 256 + tid, pair = gtid & 8191, dir = chainC >> 2;
            const unsigned* Cl = WSP(const unsigned, WS_CLOC) + (size_t)chainC * NCH * 8192 + pair; unsigned* Cs = WSP(unsigned, WS_CST) + (size_t)chainC * NCH * 8192 + pair;
            float c0 = 0.f, c1 = 0.f;
#pragma unroll 20
            for (int ci = 0; ci < NCH; ++ci) { const int pc = chain_pc(dir, ci); const f32x2 cf = coef[ci]; const unsigned w = Cl[(size_t)pc * 8192];
                Cs[(size_t)pc * 8192] = cvt_pk_bf16(c0, c1);
                c0 = cf[0] * c0 + cf[1] * bflo(w); c1 = cf[0] * c1 + cf[1] * bfhi(w); }
        } else if (gb < 4) {
            const int idx = gb * 256 + (tid - 256), chain = idx >> 7, d = idx & 127, dir = chain >> 2, ct = 1 + (chain - 2 * gb);
            const float* Nl = WSP(const float, WS_NLOC) + (size_t)chain * NCH * 128 + d; float* Ns = WSP(float, WS_NST) + (size_t)chain * NCH * 128 + d;
            float n = 0.f;
#pragma unroll 10
            for (int ci = 0; ci < NCH; ++ci) { const int pc = chain_pc(dir, ci); const f32x2 cf = coef[ct * NCH + ci]; const float w = Nl[(size_t)pc * 128];
                Ns[(size_t)pc * 128] = n; n = cf[0] * n + cf[1] * w; }
        }
        __syncthreads();
    }
    (void)lane;
}
__device__ __forceinline__ void mlstm_out_unit(const Params& P, int layer, char* lds, int pc, int h) {
    const int tid = tidx(), wid = tid >> 6, lane = tid & 63, r32 = lane & 31, hi = lane >> 5;
    char* KT = lds; char* VI = lds + 16384; char* CI = lds + 32768; float* HB = (float*)(lds + 98304);
    float* GA = (float*)(lds + 132096); float* NS = (float*)(lds + 134144); float* LI = (float*)(lds + 135168) + wid * 64;
    const float* GT = WSP(const float, WS_GATES) + (size_t)pc * 64 * 16; const bf16_t* Y = WSP(const bf16_t, WS_Y) + (size_t)pc * 64 * NINP;
    u32x4 mo0, mo1; f32x4 ngv[4];
    { const int row_ = tid >> 3, seg_ = tid & 7; const bf16_t* mo_ = Y + (size_t)row_ * NINP + C_MO + h * 128 + seg_ * 16; mo0 = *(const u32x4*)mo_; mo1 = *(const u32x4*)(mo_ + 8);
      const float* ng_ = P.m_norm_g + (size_t)layer * 512 + h * 128 + seg_ * 16;
#pragma unroll
      for (int q = 0; q < 4; ++q) ngv[q] = *(const f32x4*)(ng_ + q * 4); }
    bf16x8 qr[8];
    { const int j_ = (wid & 1) * 32 + r32; const bf16_t* qsrc = Y + (size_t)j_ * NINP + C_MQ + h * 128 + hi * 8;
#pragma unroll
      for (int d0 = 0; d0 < 8; ++d0) qr[d0] = *reinterpret_cast<const bf16x8*>(qsrc + d0 * 16); }
    u32x4 kq[2], vq[2], cq[2][4];
    { const int sr = tid >> 4, sc = (tid & 15) * 8;
#pragma unroll
      for (int q = 0; q < 2; ++q) { const int rr = sr + 32 * q; kq[q] = *(const u32x4*)(Y + (size_t)rr * NINP + C_MK + h * 128 + sc); vq[q] = *(const u32x4*)(Y + (size_t)rr * NINP + C_MV + h * 128 + sc); }
#pragma unroll
      for (int dir = 0; dir < 2; ++dir) { const bf16_t* Cs = WSP(const bf16_t, WS_CST) + ((size_t)(dir * 4 + h) * NCH + pc) * 16384;
#pragma unroll
          for (int q = 0; q < 4; ++q) { const int dk = sr + 32 * q; cq[dir][q] = *(const u32x4*)(Cs + (size_t)dk * 128 + sc); } } }
    if (wid < 2) { const int dir = wid; const bool fwd = dir == 0; const int chain = dir * 4 + h;
        const float ig = GT[lane * 16 + dir * 8 + h], lf = GT[lane * 16 + dir * 8 + 4 + h];
        float bc, a, pm; gate_scans(lf, ig, fwd, lane, bc, a, pm);
        const float ms = WSP(const float, WS_MST)[(size_t)chain * NCH + pc]; const float Mj = fmaxf(ms, pm);
        GA[dir * 64 + lane] = a; GA[128 + dir * 64 + lane] = Mj; GA[256 + dir * 64 + lane] = __expf(-(bc + Mj)); GA[384 + dir * 64 + lane] = __expf(ms - Mj);
    } else if (wid < 6) { const int idx = tid - 128, dir = idx >> 7, d = idx & 127; NS[idx] = WSP(const float, WS_NST)[((size_t)(dir * 4 + h) * NCH + pc) * 128 + d]; }
    { const int sr = tid >> 4, sc = (tid & 15) * 8;
#pragma unroll
      for (int q = 0; q < 2; ++q) { const int rr = sr + 32 * q; *(u32x4*)(KT + KSWZ(rr, sc * 2)) = kq[q]; *(u32x4*)(VI + v_st<4>(rr, sc)) = vq[q]; }
#pragma unroll
      for (int dir = 0; dir < 2; ++dir)
#pragma unroll
          for (int q = 0; q < 4; ++q) { const int dk = sr + 32 * q; *(u32x4*)(CI + dir * 32768 + (dk >> 6) * 16384 + v_st<4>(dk & 63, sc)) = cq[dir][q]; } }
    __syncthreads();
    const int rh = wid & 1, dir = (wid >> 1) & 1, vh = wid >> 2;
    {
        const int j = rh * 32 + r32;
        f32x16 p0, p1; qkt<8>(p0, p1, KT, qr, r32, hi, 0);
        const float Mj = GA[128 + dir * 64 + j], Wj = GA[384 + dir * 64 + j], Ej = GA[256 + dir * 64 + j];
        float den = 0.f;
#pragma unroll
        for (int r = 0; r < 16; ++r) { const int s0 = crow(r, hi), s1 = 32 + s0;
            const float a0 = GA[dir * 64 + s0], a1 = GA[dir * 64 + s1];
            const bool k0 = dir ? (s0 >= j) : (s0 <= j), k1 = dir ? (s1 >= j) : (s1 <= j);
            p0[r] = k0 ? p0[r] * __expf(a0 - Mj) : 0.f; p1[r] = k1 ? p1[r] * __expf(a1 - Mj) : 0.f; den += p0[r] + p1[r]; }
        { auto rr = __builtin_amdgcn_permlane32_swap(__float_as_uint(den), __float_as_uint(den), false, false); den = __uint_as_float(rr[0]) + __uint_as_float(rr[1]); }
        bf16x8 pa0, pa1, pa2, pa3; PK4(p0, 0, pa0); PK4(p0, 8, pa1); PK4(p1, 0, pa2); PK4(p1, 8, pa3);
        f32x16 o[2]; o[0] = f32x16{}; o[1] = f32x16{};
        const int vbv = lds_addr(VI) + v_rd_base(lane) + vh * 1024;
        pv_one<4, 0>(o[0], vbv, pa0, pa1, pa2, pa3); pv_one<4, 1>(o[1], vbv, pa0, pa1, pa2, pa3);
        float qn = 0.f; bf16x8 qs[8];
#pragma unroll
        for (int d0 = 0; d0 < 8; ++d0) { float qf[8];
#pragma unroll
            for (int i = 0; i < 8; ++i) { qf[i] = bf2f((bf16_t)qr[d0][i]); qn += qf[i] * NS[dir * 128 + d0 * 16 + hi * 8 + i]; qf[i] *= Wj; }
            u32x4 w; w.x = cvt_pk_bf16(qf[0], qf[1]); w.y = cvt_pk_bf16(qf[2], qf[3]); w.z = cvt_pk_bf16(qf[4], qf[5]); w.w = cvt_pk_bf16(qf[6], qf[7]); qs[d0] = *reinterpret_cast<bf16x8*>(&w); }
        { auto rr = __builtin_amdgcn_permlane32_swap(__float_as_uint(qn), __float_as_uint(qn), false, false); qn = __uint_as_float(rr[0]) + __uint_as_float(rr[1]); }
        den += Wj * qn;
        const int cb = lds_addr(CI + dir * 32768) + v_rd_base(lane) + vh * 1024;
        pv_one<4, 0>(o[0], cb, qs[0], qs[1], qs[2], qs[3]); pv_one<4, 1>(o[1], cb, qs[0], qs[1], qs[2], qs[3]);
        pv_one<4, 0>(o[0], cb + 16384, qs[4], qs[5], qs[6], qs[7]); pv_one<4, 1>(o[1], cb + 16384, qs[4], qs[5], qs[6], qs[7]);
        const float inv = 1.0f / fmaxf(fabsf(den), Ej);
        if (hi == 0) LI[r32] = inv; asm volatile("s_waitcnt lgkmcnt(0)" ::: "memory");
        float rinv[16];
#pragma unroll
        for (int r = 0; r < 16; ++r) rinv[r] = LI[crow(r, hi)];
        if (dir == 0) {
#pragma unroll
            for (int d = 0; d < 2; ++d)
#pragma unroll
                for (int r = 0; r < 16; ++r) HB[(rh * 32 + crow(r, hi)) * 132 + vh * 64 + d * 32 + r32] = o[d][r] * rinv[r];
        }
        __syncthreads();
        if (dir == 1) {
#pragma unroll
            for (int d = 0; d < 2; ++d)
#pragma unroll
                for (int r = 0; r < 16; ++r) HB[(rh * 32 + crow(r, hi)) * 132 + vh * 64 + d * 32 + r32] += o[d][r] * rinv[r];
        }
        __syncthreads();
    }
    { const int row = tid >> 3, seg = tid & 7; const float* hp = HB + row * 132 + seg * 16;
      f32x4 v[4]; float ss = 0.f;
#pragma unroll
      for (int q = 0; q < 4; ++q) { v[q] = *(const f32x4*)(hp + q * 4); ss += v[q][0] * v[q][0] + v[q][1] * v[q][1] + v[q][2] * v[q][2] + v[q][3] * v[q][3]; }
      ss += swz_xor<1>(ss); ss += swz_xor<2>(ss); ss += swz_xor<4>(ss);
      const float rs = rsqrtf(ss * (1.0f / 128.0f) + EPS);
      bf16_t* dst = WSP(bf16_t, WS_YM) + (size_t)(pc * 64 + row) * 512 + h * 128 + seg * 16;
      const u32x4 m0 = mo0, m1 = mo1;
      const float mf[16] = {bflo(m0.x), bfhi(m0.x), bflo(m0.y), bfhi(m0.y), bflo(m0.z), bfhi(m0.z), bflo(m0.w), bfhi(m0.w), bflo(m1.x), bfhi(m1.x), bflo(m1.y), bfhi(m1.y), bflo(m1.z), bfhi(m1.z), bflo(m1.w), bfhi(m1.w)};
      float ov[16];
#pragma unroll
      for (int q = 0; q < 4; ++q) { const f32x4 g = ngv[q];
#pragma unroll
          for (int i = 0; i < 4; ++i) ov[q * 4 + i] = v[q][i] * rs * g[i] * sigmoidf_(mf[q * 4 + i]); }
      u32x4 w0, w1; w0.x = cvt_pk_bf16(ov[0], ov[1]); w0.y = cvt_pk_bf16(ov[2], ov[3]); w0.z = cvt_pk_bf16(ov[4], ov[5]); w0.w = cvt_pk_bf16(ov[6], ov[7]);
      w1.x = cvt_pk_bf16(ov[8], ov[9]); w1.y = cvt_pk_bf16(ov[10], ov[11]); w1.z = cvt_pk_bf16(ov[12], ov[13]); w1.w = cvt_pk_bf16(ov[14], ov[15]);
      *(u32x4*)dst = w0; *(u32x4*)(dst + 8) = w1; }
    __syncthreads();
}

__device__ __forceinline__ void phase_mixer(const Params& P, int layer, char* lds) {
    const int G = gridDim.x, b = blockIdx.x; const bool lastl = (layer == DEPTH - 1);
    const int nA = lastl ? 512 : 520, nM3 = lastl ? 1024 : NCH * 4;
    const bool m3first = (b & 1) != 0;
    if (m3first) { for (int U = b; U < nM3; U += G) mlstm_out_unit(P, layer, lds, U >> 2, U & 3); }
    for (int U = b; U < nA; U += G) { const int head = U & 7, qb = U >> 3; attn_unit3<false>(P, layer, lds, head, qb * 256, qb < 64 ? 0 : L, qb < 64 ? LT : LC); }
    for (int U = b; U < nA; U += G) { const int pair = U & 3, qb = U >> 2; attn_unit3<true>(P, layer, lds, pair, qb * 128, qb < 128 ? 0 : L, qb < 128 ? LT : LC); }
    if (!m3first) { for (int U = b; U < nM3; U += G) mlstm_out_unit(P, layer, lds, U >> 2, U & 3); }
}

__device__ __forceinline__ void stagger_start(int nu) {
    int G = gridDim.x, c = blockIdx.x; asm volatile("" : "+s"(G), "+s"(c));
    if (units_of(nu, G, c) < units_of(nu, G, 0)) { const int k = (c >> 4) & 3; for (int t = 0; t < k; ++t) __builtin_amdgcn_s_sleep(127); }
}
__device__ __forceinline__ void phase_inproj(const Params& P, int layer, char* lds) {
    if (layer != 0) stagger_start((LT / 256) * (NINP / 256));
    pg8::DenseOrder S{LT / 256, NINP / 256, (LT / 256) * (NINP / 256), (int)gridDim.x, (int)blockIdx.x, 30, (const char*)WSP(bf16_t, WS_H), (size_t)0, (const char*)(wlayer(P, layer) + W_IN), 2048u, 2048u};
    pg8::EpiBf16 E{WSP(bf16_t, WS_Y), NINP};
    pg8::gemm_phase(( LAS unsigned char*)lds, 1024, 2048u, 2048u, S, E);
}
__device__ __forceinline__ void phase_upproj(const Params& P, int layer, char* lds) {
    { pg8::DenseOrder S{LT / 256, 3, (LT / 256) * 3, (int)gridDim.x, (int)blockIdx.x, 30, (const char*)WSP(bf16_t, WS_CQN), (size_t)0, (const char*)(wlayer(P, layer) + W_UQ), 512u, 512u};
      pg8::EpiBf16 E{WSP(bf16_t, WS_QRAW), 768};
      pg8::gemm_phase((LAS unsigned char*)lds, 256, 512u, 512u, S, E); }
    __syncthreads();
    { pg8::DenseOrder S{LT / 256, 4, (LT / 256) * 4, (int)gridDim.x, (int)blockIdx.x, 30, (const char*)WSP(bf16_t, WS_CKVN), (size_t)0, (const char*)(wlayer(P, layer) + W_UKV), 512u, 512u};
      pg8::EpiBf16HM E{WSP(bf16_t, WS_KVRAW)};
      pg8::gemm_phase((LAS unsigned char*)lds, 256, 512u, 512u, S, E); }
}
__device__ __forceinline__ void phase_merge(const Params& P, int layer, char* lds) {
    const int nM = (layer == DEPTH - 1) ? L / 256 : LT / 256;
    pg8::MergeOrder S{nM, nM * 4, (int)gridDim.x, (int)blockIdx.x, (const char*)WSP(bf16_t, WS_YM), (size_t)(WS_YA - WS_YM), (const char*)(wlayer(P, layer) + W_BR), 1024u, 1024u};
    pg8::EpiGate E{WSP(bf16_t, WS_ZCAT), 1024, WSP(const bf16_t, WS_Y) + C_GL, NINP};
    pg8::gemm_phase((LAS unsigned char*)lds, 512, 1024u, 1024u, S, E);
}
__device__ __forceinline__ void phase_wout(const Params& P, int layer, char* lds) {
    const int nM = (layer == DEPTH - 1) ? L / 256 : LT / 256;
    pg8::DenseOrder S{nM, 4, nM * 4, (int)gridDim.x, (int)blockIdx.x, 30, (const char*)WSP(bf16_t, WS_ZCAT), (size_t)0, (const char*)(wlayer(P, layer) + W_OUT3), 2048u, 6144u};
    pg8::EpiBf16 E{WSP(bf16_t, WS_YMIX), 1024};
    pg8::gemm_phase((LAS unsigned char*)lds, 1024, 2048u, 6144u, S, E);
}
constexpr int MOE_TAB_OFF = 131072, MOE_MAP_OFF = 131072 + 1280, MOE_MAXU = 10;
__device__ __forceinline__ const LAS int* moe_table(const int* TI, int nt, char* lds) {
    LAS int* ltab = (LAS int*)((LAS unsigned char*)lds + MOE_TAB_OFF);
    for (int t = tidx(); t < nt; t += NTHR) ltab[t] = TI[64 + t];
    __syncthreads();
    return ltab;
}
__device__ __forceinline__ void phase_moe_gu(const Params& P, int layer, char* lds) {
    const int* TI = WSP(const int, WS_TILE) + layer * 512; const int nt = TI[0];
    stagger_start(nt * 8);
    const LAS int* ltab = moe_table(TI, nt, lds);
    pg8::MoeOrder S{nt, 8, nt * 8, (int)gridDim.x, (int)blockIdx.x, ltab, nullptr, (const char*)(wlayer(P, layer) + W_GU), 2048u, 2048u, (size_t)2048 * 1024 * 2};
    LAS int* lmap = (LAS int*)((LAS unsigned char*)lds + MOE_MAP_OFF);
    { const int tid = tidx(); const int* XS = WSP(const int, WS_XS); unsigned rv[MOE_MAXU];
      if (tid < 256) {
#pragma unroll
          for (int i = 0; i < MOE_MAXU; ++i) { const int pm = S.pm_of(i); rv[i] = (unsigned)XS[(pm >= 0 ? pm : 0) * 256 + tid]; }
#pragma unroll
          for (int i = 0; i < MOE_MAXU; ++i) lmap[i * 256 + tid] = (int)(rv[i] < (unsigned)LT ? rv[i] : (unsigned)LT); }
      __syncthreads(); }
    pg8::EpiSwiglu E{WSP(bf16_t, WS_ACT), P.b_gu + (size_t)layer * NE * 2048, ltab};
    pg8::gemm_phase_gather((LAS unsigned char*)lds, 1024, 2048u, 2048u, S, E, (const char*)WSP(bf16_t, WS_H), lmap);
}
__device__ __forceinline__ void phase_moe_down(const Params& P, int layer, char* lds) {
    const int* TI = WSP(const int, WS_TILE) + layer * 512; const int nt = TI[0];
    stagger_start(nt * 4);
    const LAS int* ltab = moe_table(TI, nt, lds);
    pg8::MoeOrder S{nt, 4, nt * 4, (int)gridDim.x, (int)blockIdx.x, ltab, (const char*)WSP(bf16_t, WS_ACT), (const char*)(wlayer(P, layer) + W_DN), 2048u, 2048u, (size_t)1024 * 1024 * 2};
    pg8::EpiDown E{WSP(bf16_t, WS_YS), P.b_down + (size_t)layer * NE * 1024, ltab};
    pg8::gemm_phase((LAS unsigned char*)lds, 1024, 2048u, 2048u, S, E);
}
__global__ void __launch_bounds__(NTHR, 2) k_mega(Params P) {
    extern __shared__ __attribute__((aligned(16))) char shm[];
    tid_setup();
    volatile LAS unsigned* st = (volatile LAS unsigned*)(shm + LDS_BYTES - 16);
    if (tidx() == 0) { st[0] = 0u; st[1] = 0u; st[2] = 0u; st[3] = 0u; }
    __syncthreads();
    (void)xcd_barrier_post(WSP(unsigned, WS_BAR), st);
#define GRID_BAR() do { XcdBarrier b_; b_.bar = WSP(unsigned, WS_BAR); b_.x = xb_xcc_id(); b_.st = st; xcd_barrier(b_); } while (0)
    phase_p0(P, shm);
    GRID_BAR();
    _Pragma("unroll 1") for (int layer = 0; layer < DEPTH; ++layer) {
        if (layer == 0) { phase_modulate1(P, layer);                 GRID_BAR(); }
        phase_inproj(P, layer, shm);
        if (layer == 0) { const int G = gridDim.x, nu = (LT / 256) * (NINP / 256); if (units_of(nu, G, blockIdx.x) < units_of(nu, G, 0)) conv_pull(P, shm, 6); }
                                                                     GRID_BAR();
        phase_prep(P, layer); phase_mlstm_local(P, layer, shm);      GRID_BAR();
        phase_mlstm_scan(P, shm); phase_upproj(P, layer, shm);       GRID_BAR();
        phase_mixer(P, layer, shm);                                  GRID_BAR();
        phase_merge(P, layer, shm);
        if (layer == 0) { const int G = gridDim.x, nu = (LT / 256) * 4; if (units_of(nu, G, blockIdx.x) < units_of(nu, G, 0)) conv_pull(P, shm, 10); }
                                                                     GRID_BAR();
        phase_wout(P, layer, shm);
        if (layer == 0) { const int G = gridDim.x, nu = (LT / 256) * 4; if (units_of(nu, G, blockIdx.x) < units_of(nu, G, 0)) conv_pull(P, shm, 6); }
                                                                     GRID_BAR();
        phase_postmix(P, layer, shm);                                GRID_BAR();
        phase_gather(P, layer, shm);                                 GRID_BAR();
        phase_moe_gu(P, layer, shm);                                 GRID_BAR();
        phase_moe_down(P, layer, shm);                               GRID_BAR();
        phase_combine(P, layer);                                     if (layer == 0) conv_pull(P, shm, -1);
                                                                     if (layer + 1 < DEPTH) GRID_BAR();
    }
}

extern "C" void kernel_launch(void* const* d_in, const int* in_sizes, int n_in, void* d_out, int out_size, void* d_ws, size_t ws_size, hipStream_t stream) {
    (void)in_sizes; (void)n_in; (void)out_size;
    if (ws_size < WS_END) return;
    static int grid = 0;
    if (grid == 0) {
        int dev = 0, cus = 0, per_cu = 0;
        (void)hipGetDevice(&dev);
        (void)hipDeviceGetAttribute(&cus, hipDeviceAttributeMultiprocessorCount, dev);
        (void)hipFuncSetAttribute((const void*)k_mega, hipFuncAttributeMaxDynamicSharedMemorySize, LDS_BYTES);
        (void)hipOccupancyMaxActiveBlocksPerMultiprocessor(&per_cu, (const void*)k_mega, NTHR, LDS_BYTES);
        (void)hipGetLastError();
        if (cus <= 0) cus = 256;
        grid = cus;
    }
    Params P{};
    const float** pp = (const float**)&P;
    for (int i = 0; i < 24; ++i) pp[i] = (const float*)d_in[i];
    P.out = (float*)d_out; P.ws = (unsigned char*)d_ws;
    (void)hipMemsetAsync((char*)d_ws + WS_BAR, 0, 16384, stream);
    hipLaunchKernelGGL(k_mega, dim3(grid), dim3(NTHR), LDS_BYTES, stream, P);
}
```
